# Optimizing an MI355X kernel written in HIP

```python
import math
import jax, jax.numpy as jnp
from jax import lax
import numpy as np

D_MODEL = 1024
BATCH = 2
SEQ = 8192
DEPTH = 1
DEC_BATCH = 8
DEC_SEQ = 32
PAST_LEN = 4096

CHUNK = 64
MIX_WIDTH = D_MODEL
MLSTM_WIDTH = MIX_WIDTH // 2
MLSTM_HEADS = 4
QK_DIM = MLSTM_WIDTH // MLSTM_HEADS
V_DIM = MLSTM_WIDTH // MLSTM_HEADS
ATT_WIDTH = MIX_WIDTH - MLSTM_WIDTH
ATT_HEADS = 8
ATT_HEAD_DIM = ATT_WIDTH // ATT_HEADS
KV_HEADS = 2
GQA_GROUP = ATT_HEADS // KV_HEADS
WINDOW = 128
WINDOW_CHUNKS = WINDOW // CHUNK
D_FF = 4 * D_MODEL
PLE_DIM = 256
EPS = 1e-6
PROJ_SIZES = (MLSTM_WIDTH, MLSTM_WIDTH, MLSTM_WIDTH, MLSTM_WIDTH, MLSTM_HEADS, MLSTM_HEADS,
              ATT_WIDTH, KV_HEADS * ATT_HEAD_DIM, KV_HEADS * ATT_HEAD_DIM)
PROJ_WIDTH = sum(PROJ_SIZES)

kernel_name = "hymba_mlstm_swa_sink_alibi_stream_step"


def _rmsnorm(x, g):
    x32 = x.astype(jnp.float32)
    y = x32 * lax.rsqrt(jnp.mean(x32 * x32, axis=-1, keepdims=True) + EPS)
    return (y * g.astype(jnp.float32)).astype(x.dtype)


def _split_cols(proj):
    outs, off = [], 0
    for s in PROJ_SIZES:
        outs.append(proj[..., off:off + s])
        off += s
    return outs


def _alibi_slopes():
    return 2.0 ** (-(jnp.arange(1, ATT_HEADS + 1, dtype=jnp.float32) * (8.0 / ATT_HEADS)))


def _mlstm_chunkwise(q, k, v, i_pre, f_pre, c0, n0, m0, chunk):
    B, S, H, dk = q.shape
    dv = v.shape[-1]
    nc = S // chunk
    f32 = jnp.float32

    def to_chunks(a):
        a = a.astype(f32).reshape((B, nc, chunk, H) + a.shape[3:])
        return jnp.moveaxis(jnp.moveaxis(a, 1, 0), 3, 2)

    qc, kc, vc = to_chunks(q), to_chunks(k), to_chunks(v)
    ic, lfc = to_chunks(i_pre), to_chunks(jax.nn.log_sigmoid(f_pre.astype(f32)))
    causal = jnp.tril(jnp.ones((chunk, chunk), dtype=bool))

    def step(carry, xs):
        c, n, m = carry
        qb, kb, vb, ib, lfb = xs
        b = jnp.cumsum(lfb, axis=-1)
        a = b + m[..., None]
        dmat = jnp.where(causal, b[..., :, None] - b[..., None, :] + ib[..., None, :], -jnp.inf)
        mt = jnp.maximum(a, jnp.max(dmat, axis=-1))
        w_inter = jnp.exp(a - mt)
        s = jnp.einsum('bhtd,bhsd->bhts', qb, kb) * jnp.exp(dmat - mt[..., None])
        num = jnp.einsum('bhts,bhsv->bhtv', s, vb) + w_inter[..., None] * jnp.einsum('bhtd,bhdv->bhtv', qb, c)
        den = jnp.sum(s, axis=-1) + w_inter * jnp.einsum('bhtd,bhd->bht', qb, n)
        h = num / jnp.maximum(jnp.abs(den), jnp.exp(-mt))[..., None]
        m_new = mt[..., -1]
        w_c = jnp.exp(b[..., -1] + m - m_new)
        w_s = jnp.exp(b[..., -1:] - b + ib - m_new[..., None])
        c_new = w_c[..., None, None] * c + jnp.einsum('bhs,bhsd,bhsv->bhdv', w_s, kb, vb)
        n_new = w_c[..., None] * n + jnp.einsum('bhs,bhsd->bhd', w_s, kb)
        return (c_new, n_new, m_new), h

    (c1, n1, m1), hs = lax.scan(step, (c0.astype(f32), n0.astype(f32), m0.astype(f32)),
                                (qc, kc, vc, ic, lfc))
    hs = jnp.moveaxis(jnp.moveaxis(hs, 2, 3), 0, 1).reshape(B, S, H, dv)
    return hs.astype(q.dtype), c1, n1, m1


def _swa_attention(qb, kb, vb, q_pos, k_pos, sinks):
    f32 = jnp.float32
    s = jnp.einsum('bnqkgd,bnskd->bnkgqs', qb.astype(f32), kb.astype(f32)) * (ATT_HEAD_DIM ** -0.5)
    qp, kp = q_pos[:, :, None], k_pos[:, None, :]
    cdiff = qp // CHUNK - kp // CHUNK
    mask = (cdiff >= 0) & (cdiff <= WINDOW_CHUNKS) & (kp >= 0)
    dist = jnp.abs(qp - kp).astype(f32)
    slopes = _alibi_slopes().reshape(KV_HEADS, GQA_GROUP)
    s = s - slopes[None, None, :, :, None, None] * dist[None, :, None, None]
    s = jnp.where(mask[None, :, None, None], s, -jnp.inf)
    sink = sinks.astype(f32).reshape(KV_HEADS, GQA_GROUP)[None, None, :, :, None]
    mx = jnp.maximum(jnp.max(s, axis=-1), sink)
    p = jnp.exp(s - mx[..., None])
    den = jnp.sum(p, axis=-1) + jnp.exp(sink - mx)
    o = jnp.einsum('bnkgqs,bnskd->bnqkgd', p / den[..., None], vb.astype(f32))
    B, N, Lq = o.shape[:3]
    return o.reshape(B, N * Lq, ATT_WIDTH).astype(qb.dtype)


def _layer(x, p, c0, n0, m0, cache_k, cache_v, n_keep, prompt,
           g_mix, w_in, b_igate, b_fgate, g_head, attn_sinks, w_out,
           g_mlp, w_up, w_down, g_ple, w_ple_gate, w_ple_proj):
    B, S, _ = x.shape
    h = _rmsnorm(x, g_mix)
    q_m, k_m, v_m, o_m, i_pre, f_pre, q_a, k_a, v_a = _split_cols(h @ w_in)

    qm = q_m.reshape(B, S, MLSTM_HEADS, QK_DIM)
    km = k_m.reshape(B, S, MLSTM_HEADS, QK_DIM) * (QK_DIM ** -0.5)
    vm = v_m.reshape(B, S, MLSTM_HEADS, V_DIM)
    chunk = CHUNK if prompt else S
    h_til, c1, n1, m1 = _mlstm_chunkwise(qm, km, vm, i_pre + b_igate, f_pre + b_fgate,
                                         c0, n0, m0, chunk)
    h_m = jax.nn.sigmoid(o_m) * _rmsnorm(h_til, g_head.reshape(MLSTM_HEADS, V_DIM)).reshape(B, S, MLSTM_WIDTH)

    qa = q_a.reshape(B, S, KV_HEADS, GQA_GROUP, ATT_HEAD_DIM)
    ka = k_a.reshape(B, S, KV_HEADS, ATT_HEAD_DIM)
    va = v_a.reshape(B, S, KV_HEADS, ATT_HEAD_DIM)
    if prompt:
        nc = S // CHUNK
        pad = WINDOW_CHUNKS * CHUNK
        band = lambda a: jnp.concatenate(
            [a[:, j:j + nc] for j in range(WINDOW_CHUNKS + 1)], axis=2)
        kp = jnp.pad(ka, ((0, 0), (pad, 0), (0, 0), (0, 0))).reshape(B, nc + WINDOW_CHUNKS, CHUNK, KV_HEADS, ATT_HEAD_DIM)
        vp = jnp.pad(va, ((0, 0), (pad, 0), (0, 0), (0, 0))).reshape(B, nc + WINDOW_CHUNKS, CHUNK, KV_HEADS, ATT_HEAD_DIM)
        kb, vb = band(kp), band(vp)
        qb = qa.reshape(B, nc, CHUNK, KV_HEADS, GQA_GROUP, ATT_HEAD_DIM)
        q_pos = jnp.arange(S, dtype=jnp.int32).reshape(nc, CHUNK)
        k_pos = (jnp.arange(nc, dtype=jnp.int32) * CHUNK)[:, None] - pad + \
            jnp.arange((WINDOW_CHUNKS + 1) * CHUNK, dtype=jnp.int32)[None, :]
        k_all, v_all = ka, va
    else:
        k_all = jnp.concatenate([cache_k.astype(ka.dtype), ka], axis=1)
        v_all = jnp.concatenate([cache_v.astype(va.dtype), va], axis=1)
        kb, vb, qb = k_all[:, None], v_all[:, None], qa[:, None]
        q_pos = (PAST_LEN + jnp.arange(S, dtype=jnp.int32))[None]
        k_pos = (PAST_LEN - n_keep + jnp.arange(n_keep + S, dtype=jnp.int32))[None]
    o_a = _swa_attention(qb, kb, vb, q_pos, k_pos, attn_sinks)
    new_k, new_v = k_all[:, -n_keep:], v_all[:, -n_keep:]

    x = x + jnp.concatenate([h_m, o_a], axis=-1) @ w_out
    x = x + jnp.square(jax.nn.relu(_rmsnorm(x, g_mlp) @ w_up)) @ w_down
    x = x + jax.nn.sigmoid(_rmsnorm(x, g_ple) @ w_ple_gate) * (p @ w_ple_proj)
    return x, new_k, new_v, c1, n1, m1


def setup_inputs(seed: int = 0) -> dict:
    key = jax.random.key(seed)
    ks = jax.random.split(key, 24)
    nrm = lambda k, shape, scale: jax.random.normal(k, shape, jnp.float32) * scale
    w_keep = min(WINDOW, PAST_LEN)
    return {
        "x_prompt": nrm(ks[0], (BATCH, SEQ, D_MODEL), 1.0),
        "x_sample": nrm(ks[1], (DEC_BATCH, DEC_SEQ, D_MODEL), 1.0),
        "cache_swa_k": nrm(ks[2], (DEPTH, DEC_BATCH, w_keep, KV_HEADS, ATT_HEAD_DIM), 1.0),
        "cache_swa_v": nrm(ks[3], (DEPTH, DEC_BATCH, w_keep, KV_HEADS, ATT_HEAD_DIM), 1.0),
        "state_mlstm_c": nrm(ks[4], (DEPTH, DEC_BATCH, MLSTM_HEADS, QK_DIM, V_DIM), 0.1),
        "state_mlstm_n": nrm(ks[5], (DEPTH, DEC_BATCH, MLSTM_HEADS, QK_DIM), 0.1),
        "state_mlstm_m": nrm(ks[6], (DEPTH, DEC_BATCH, MLSTM_HEADS), 1.0),
        "p_prompt": nrm(ks[7], (DEPTH, BATCH, SEQ, PLE_DIM), 1.0),
        "p_sample": nrm(ks[8], (DEPTH, DEC_BATCH, DEC_SEQ, PLE_DIM), 1.0),
        "g_mix": 1.0 + nrm(ks[9], (DEPTH, D_MODEL), 0.02),
        "w_in": nrm(ks[10], (DEPTH, D_MODEL, PROJ_WIDTH), D_MODEL ** -0.5),
        "b_igate": nrm(ks[11], (DEPTH, MLSTM_HEADS), 0.1),
        "b_fgate": 3.0 + nrm(ks[12], (DEPTH, MLSTM_HEADS), 0.1),
        "g_head": 1.0 + nrm(ks[13], (DEPTH, MLSTM_WIDTH), 0.02),
        "attn_sinks": nrm(ks[14], (DEPTH, ATT_HEADS), 0.5),
        "w_out": nrm(ks[15], (DEPTH, MIX_WIDTH, D_MODEL), MIX_WIDTH ** -0.5),
        "g_mlp": 1.0 + nrm(ks[16], (DEPTH, D_MODEL), 0.02),
        "w_up": nrm(ks[17], (DEPTH, D_MODEL, D_FF), D_MODEL ** -0.5),
        "w_down": nrm(ks[18], (DEPTH, D_FF, D_MODEL), D_FF ** -0.5),
        "g_ple": 1.0 + nrm(ks[19], (DEPTH, D_MODEL), 0.02),
        "w_ple_gate": nrm(ks[20], (DEPTH, D_MODEL, D_MODEL), D_MODEL ** -0.5),
        "w_ple_proj": nrm(ks[21], (DEPTH, PLE_DIM, D_MODEL), PLE_DIM ** -0.5),
        "g_final": 1.0 + nrm(ks[22], (D_MODEL,), 0.02),
    }


def reference(x_prompt, x_sample, cache_swa_k, cache_swa_v, state_mlstm_c, state_mlstm_n,
              state_mlstm_m, p_prompt, p_sample, g_mix, w_in, b_igate, b_fgate, g_head,
              attn_sinks, w_out, g_mlp, w_up, w_down, g_ple, w_ple_gate, w_ple_proj, g_final):
    n_keep = cache_swa_k.shape[2]
    xp, xs = x_prompt, x_sample
    pk, pv, pc, pn, pm = [], [], [], [], []
    sk, sv, sc, sn, sm = [], [], [], [], []
    for l in range(DEPTH):
        lw = (g_mix[l], w_in[l], b_igate[l], b_fgate[l], g_head[l], attn_sinks[l], w_out[l],
              g_mlp[l], w_up[l], w_down[l], g_ple[l], w_ple_gate[l], w_ple_proj[l])
        zc = jnp.zeros((BATCH, MLSTM_HEADS, QK_DIM, V_DIM), jnp.float32)
        zn = jnp.zeros((BATCH, MLSTM_HEADS, QK_DIM), jnp.float32)
        zm = jnp.zeros((BATCH, MLSTM_HEADS), jnp.float32)
        xp, k1, v1, c1, n1, m1 = _layer(xp, p_prompt[l], zc, zn, zm, None, None, n_keep, True, *lw)
        xs, k2, v2, c2, n2, m2 = _layer(xs, p_sample[l], state_mlstm_c[l], state_mlstm_n[l],
                                        state_mlstm_m[l], cache_swa_k[l], cache_swa_v[l],
                                        n_keep, False, *lw)
        pk.append(k1); pv.append(v1); pc.append(c1); pn.append(n1); pm.append(m1)
        sk.append(k2); sv.append(v2); sc.append(c2); sn.append(n2); sm.append(m2)
    y_prompt = _rmsnorm(xp, g_final)
    y_sample = _rmsnorm(xs, g_final)
    return (y_prompt, y_sample,
            jnp.stack(pk), jnp.stack(pv), jnp.stack(pc), jnp.stack(pn), jnp.stack(pm),
            jnp.stack(sk), jnp.stack(sv), jnp.stack(sc), jnp.stack(sn), jnp.stack(sm))
```

```cpp
#include <hip/hip_runtime.h>
#include <hip/hip_cooperative_groups.h>
#include <cstdio>
#include <cstdint>
namespace cg = cooperative_groups;
namespace pg8 {
#define PG8_LAS __attribute__((address_space(3)))
typedef unsigned short bf16_t;
typedef short bf16x8 __attribute__((ext_vector_type(8)));
typedef float f32x4 __attribute__((ext_vector_type(4)));
typedef unsigned u32x4 __attribute__((ext_vector_type(4)));
constexpr int BM = 256, BK = 64, HALF = 128, HTB = HALF * BK * 2  , STAGE_BYTES = 8 * HTB, NXCD = 8, WGM = 4;

__host__ __device__ __forceinline__ int lds_byte(int r, int c) { const int st = (r >> 4) * 2 + (c >> 5), rr = r & 15, cc = c & 31, ob = rr * 64 + cc * 2; return st * 1024 + (ob ^ (((ob >> 9) & 1) << 5)); }
__host__ __device__ __forceinline__ void stage_rc(int b, int& R, int& C) { const int st = b / 1024, sb = b % 1024, swz = sb ^ (((sb >> 9) & 1) << 5); R = (st >> 1) * 16 + swz / 64; C = (st & 1) * 32 + (swz % 64) / 2; }
__host__ __device__ __forceinline__ int perm32(int rho) { const int n = rho >> 4, i = rho & 15; return 8 * (i >> 2) + 4 * n + (i & 3); }

struct Unit { int pm, pn; };
struct Gemm { const bf16_t* A; const bf16_t* Bt; int M, N, K; };

struct StaticOrder {
    int nM, nN, nwg, G, c;
    __host__ __device__ void init(int M, int N, int G_, int c_) { nM = M / BM; nN = N / BM; nwg = nM * nN; G = G_; c = c_; }
    __host__ __device__ bool next(int i, Unit& u) const {
        const long L = (long)i * G + c; if (L >= nwg) return false;
        int wgid = (int)L; { const int q = nwg / NXCD, r = nwg % NXCD, xcd = wgid % NXCD, off = wgid / NXCD; wgid = (xcd < r ? xcd * (q + 1) : r * (q + 1) + (xcd - r) * q) + off; }
        const int nig = WGM * nN, gid = wgid / nig, fm = gid * WGM, gsz = (nM - fm) < WGM ? (nM - fm) : WGM;
        u.pm = fm + ((wgid % nig) % gsz); u.pn = (wgid % nig) / gsz; return true;
    }
    __device__ __forceinline__ void a_ready(const Unit&) const {}
    __device__ __forceinline__ void done(const Unit&) const {}
};

__device__ __forceinline__ unsigned cvt_pk_bf16(float lo, float hi) { unsigned r; asm volatile("v_cvt_pk_bf16_f32 %0, %1, %2" : "=v"(r) : "v"(lo), "v"(hi)); return r; }
template <class Epi, class Sched, bool ALIGN_EPI = false, bool SP2 = false>
__device__ __forceinline__ void gemm_phase(PG8_LAS unsigned char* lds, const Gemm g, const Sched& S, const Epi& E) {
    const int tid = threadIdx.x, wid = __builtin_amdgcn_readfirstlane(tid >> 6), lane = tid & 63, wr = wid >> 2, wc = wid & 3, fr = lane & 15, fq = lane >> 4;
    const int K = g.K, nt = K / BK;
    unsigned voffA[2], voffB[2];
#pragma unroll
    for (int i = 0; i < 2; ++i) { int R, C; stage_rc(tid * 16 + i * 8192, R, C); const int Rb = Epi::PERM ? ((R & ~31) + perm32(R & 31)) : R;
        voffA[i] = (unsigned)(R * K + C) * 2u; voffB[i] = (unsigned)(Rb * K + C) * 2u; }
    const size_t kstep = (size_t)(BK * 2);
    const size_t hstep = (size_t)HALF * K * 2;
    const size_t tstep = 2 * hstep;
    const unsigned ldsw = (unsigned)wid * 1024u;
    const int aoff = lds_byte(wr * 64 + fr, fq * 8), boff = lds_byte(wc * 32 + fr, fq * 8);
#define PG8_SA(b, h) (((b) * 2 + (h)) * HTB)
#define PG8_SB(b, h) ((4 + (b) * 2 + (h)) * HTB)
#define PG8_STAGE(bufoff, gbase, voff) do { _Pragma("unroll") for (int _i = 0; _i < 2; ++_i) \
        __builtin_amdgcn_global_load_lds((const unsigned*)((const char*)(gbase) + (voff)[_i]), (PG8_LAS unsigned*)(lds + (bufoff) + ldsw + _i * 8192), 16, 0, 0); } while (0)
#define PG8_LDA(dst, b, h) do { _Pragma("unroll") for (int m = 0; m < 4; ++m) _Pragma("unroll") for (int k = 0; k < 2; ++k) dst[m][k] = *(const PG8_LAS bf16x8*)(lds + PG8_SA(b, h) + aoff + m * 2048 + k * 1024); } while (0)
#define PG8_LDB(dst, b, h) do { _Pragma("unroll") for (int n = 0; n < 2; ++n) _Pragma("unroll") for (int k = 0; k < 2; ++k) dst[n][k] = *(const PG8_LAS bf16x8*)(lds + PG8_SB(b, h) + boff + n * 2048 + k * 1024); } while (0)
#define PG8_MMA(ai, bj, At, Bt) do { __builtin_amdgcn_s_setprio(1); _Pragma("unroll") for (int m = 0; m < 4; ++m) _Pragma("unroll") for (int n = 0; n < 2; ++n) _Pragma("unroll") for (int k = 0; k < 2; ++k) \
        acc[ai][bj][m][n] = __builtin_amdgcn_mfma_f32_16x16x32_bf16(Bt[n][k], At[m][k], acc[ai][bj][m][n], 0, 0, 0); __builtin_amdgcn_s_setprio(0); } while (0)
#define PG8_WAIT_V(n) asm volatile("s_waitcnt vmcnt(" #n ")" ::: "memory")
#define PG8_WAIT_L(n) asm volatile("s_waitcnt lgkmcnt(" #n ")" ::: "memory")
#define PG8_BAR __builtin_amdgcn_s_barrier()
#define PG8_SCHED __builtin_amdgcn_sched_barrier(0)
    Unit cur, nxt; int ui = 0;
    if (!S.next(0, cur)) return;
    f32x4 acc[2][2][4][2];
#pragma unroll
    for (int a = 0; a < 2; ++a)
#pragma unroll
        for (int b = 0; b < 2; ++b)
#pragma unroll
            for (int m = 0; m < 4; ++m)
#pragma unroll
                for (int n = 0; n < 2; ++n) acc[a][b][m][n] = (f32x4){0.f, 0.f, 0.f, 0.f};
    bf16x8 At[4][2], B0[2][2], B1[2][2];
    const char* cA = (const char*)g.A + (size_t)cur.pm * tstep; const char* cB = (const char*)g.Bt + (size_t)cur.pn * tstep;
    S.a_ready(cur);
    if constexpr (SP2) {
        PG8_STAGE(PG8_SB(0, 0), cB, voffB); PG8_STAGE(PG8_SB(0, 1), cB + hstep, voffB); PG8_STAGE(PG8_SA(0, 0), cA, voffA); PG8_STAGE(PG8_SA(0, 1), cA + hstep, voffA);
        if (wr == 1) PG8_BAR;
        PG8_WAIT_V(2); PG8_BAR;
        PG8_STAGE(PG8_SB(1, 0), cB + kstep, voffB); PG8_STAGE(PG8_SA(1, 0), cA + kstep, voffA); PG8_STAGE(PG8_SB(1, 1), cB + hstep + kstep, voffB);
        PG8_WAIT_V(6); PG8_BAR;
    } else {
        PG8_STAGE(PG8_SB(0, 0), cB, voffB); PG8_STAGE(PG8_SA(0, 0), cA, voffA); PG8_STAGE(PG8_SB(0, 1), cB + hstep, voffB); PG8_STAGE(PG8_SA(0, 1), cA + hstep, voffA);
        if (wr == 1) PG8_BAR;
        PG8_WAIT_V(4); PG8_BAR;
        PG8_STAGE(PG8_SB(1, 0), cB + kstep, voffB); PG8_STAGE(PG8_SA(1, 0), cA + kstep, voffA); PG8_STAGE(PG8_SB(1, 1), cB + hstep + kstep, voffB);
        PG8_WAIT_V(6); PG8_BAR;
    }
    for (;;) {
        const bool has_next = S.next(ui + 1, nxt);
        const char* nA = has_next ? (const char*)g.A + (size_t)nxt.pm * tstep : cA; const char* nB = has_next ? (const char*)g.Bt + (size_t)nxt.pn * tstep : cB;
        for (int t = 0; t < nt; t += 2) {
            const bool last = (t == nt - 2);
            const char* a1 = cA + (size_t)(t + 1) * kstep;
            const char* a2 = last ? nA : cA + (size_t)(t + 2) * kstep; const char* b2 = last ? nB : cB + (size_t)(t + 2) * kstep;
            const char* a3 = a2 + kstep; const char* b3 = b2 + kstep;
            if (last && has_next) S.a_ready(nxt);
            if constexpr (SP2) {
            PG8_LDB(B0, 0, 0); PG8_LDB(B1, 0, 1); PG8_SCHED; PG8_LDA(At, 0, 0); PG8_STAGE(PG8_SA(1, 1), a1 + hstep, voffA);
            PG8_WAIT_V(8); PG8_WAIT_L(0); PG8_BAR; PG8_MMA(0, 0, At, B0); PG8_MMA(0, 1, At, B1); PG8_BAR; PG8_SCHED;
            PG8_LDA(At, 0, 1); PG8_STAGE(PG8_SB(0, 0), b2, voffB); PG8_STAGE(PG8_SB(0, 1), b2 + hstep, voffB); PG8_STAGE(PG8_SA(0, 0), a2, voffA);
            PG8_WAIT_V(8); PG8_WAIT_L(0); PG8_BAR; PG8_MMA(1, 0, At, B0); PG8_MMA(1, 1, At, B1); PG8_BAR; PG8_SCHED;
            PG8_LDB(B0, 1, 0); PG8_LDB(B1, 1, 1); PG8_SCHED; PG8_LDA(At, 1, 0); PG8_STAGE(PG8_SA(0, 1), a2 + hstep, voffA);
            PG8_WAIT_V(8); PG8_WAIT_L(0); PG8_BAR; PG8_MMA(0, 0, At, B0); PG8_MMA(0, 1, At, B1); PG8_BAR; PG8_SCHED;
            PG8_LDA(At, 1, 1); PG8_STAGE(PG8_SB(1, 0), b3, voffB); PG8_STAGE(PG8_SB(1, 1), b3 + hstep, voffB); PG8_STAGE(PG8_SA(1, 0), a3, voffA);
            PG8_WAIT_V(8); PG8_WAIT_L(0); PG8_BAR; PG8_MMA(1, 0, At, B0); PG8_MMA(1, 1, At, B1); PG8_BAR; PG8_SCHED;
            } else {
            PG8_LDB(B0, 0, 0); PG8_SCHED; PG8_LDA(At, 0, 0); PG8_STAGE(PG8_SA(1, 1), a1 + hstep, voffA);
            PG8_WAIT_L(8); PG8_BAR; PG8_WAIT_L(0); PG8_MMA(0, 0, At, B0); PG8_BAR; PG8_SCHED;
            PG8_LDB(B1, 0, 1); PG8_STAGE(PG8_SB(0, 0), b2, voffB);
            PG8_BAR; PG8_WAIT_L(0); PG8_MMA(0, 1, At, B1); PG8_BAR;
            PG8_LDA(At, 0, 1); PG8_STAGE(PG8_SA(0, 0), a2, voffA);
            PG8_BAR; PG8_WAIT_L(0); PG8_MMA(1, 0, At, B0); PG8_BAR; PG8_SCHED;
            PG8_STAGE(PG8_SB(0, 1), b2 + hstep, voffB);
            PG8_WAIT_V(6); PG8_BAR; PG8_MMA(1, 1, At, B1); PG8_BAR;
            PG8_LDB(B0, 1, 0); PG8_SCHED; PG8_LDA(At, 1, 0); PG8_STAGE(PG8_SA(0, 1), a2 + hstep, voffA);
            PG8_WAIT_L(8); PG8_BAR; PG8_WAIT_L(0); PG8_MMA(0, 0, At, B0); PG8_BAR; PG8_SCHED;
            PG8_LDB(B1, 1, 1); PG8_STAGE(PG8_SB(1, 0), b3, voffB);
            PG8_BAR; PG8_WAIT_L(0); PG8_MMA(0, 1, At, B1); PG8_BAR;
            PG8_LDA(At, 1, 1); PG8_STAGE(PG8_SA(1, 0), a3, voffA);
            PG8_BAR; PG8_WAIT_L(0); PG8_MMA(1, 0, At, B0); PG8_BAR; PG8_SCHED;
            PG8_STAGE(PG8_SB(1, 1), b3 + hstep, voffB);
            PG8_WAIT_V(6); PG8_BAR; PG8_MMA(1, 1, At, B1); PG8_BAR;
            }
        }
        if constexpr (ALIGN_EPI) { if (wr == 0) PG8_BAR; }
        if constexpr (!Epi::AFTER_DRAIN) { E(acc, cur, wr, wc, fr, fq); S.done(cur); }
        if (!has_next) break;
#pragma unroll
        for (int a = 0; a < 2; ++a)
#pragma unroll
            for (int b = 0; b < 2; ++b)
#pragma unroll
                for (int m = 0; m < 4; ++m)
#pragma unroll
                    for (int n = 0; n < 2; ++n) acc[a][b][m][n] = (f32x4){0.f, 0.f, 0.f, 0.f};
        cur = nxt; cA = nA; cB = nB; ++ui;
        if constexpr (ALIGN_EPI) { if (wr == 1) PG8_BAR; }
    }
    PG8_WAIT_V(0);
    if constexpr (!ALIGN_EPI) { if (wr == 0) PG8_BAR; }
    PG8_BAR;
    if constexpr (Epi::AFTER_DRAIN) { E.fused(acc, cur, wr, wc, fr, fq, lds, wid, lane); S.done(cur); }
#undef PG8_SA
#undef PG8_SB
#undef PG8_STAGE
#undef PG8_LDA
#undef PG8_LDB
#undef PG8_MMA
#undef PG8_WAIT_V
#undef PG8_WAIT_L
#undef PG8_BAR
#undef PG8_SCHED
}
}
#ifndef FUSE_FINAL
#define FUSE_FINAL 0
#endif
#ifndef PP_IN_P1
#define PP_IN_P1 0
#endif
#ifndef SMALL_REP
#define SMALL_REP 1
#endif

using pg8::bf16x8; using pg8::f32x4; using pg8::u32x4;
typedef unsigned short bf16;
typedef float f32x16 __attribute__((ext_vector_type(16)));
typedef float f32x2_t __attribute__((ext_vector_type(2)));
typedef __bf16 bf16x2_t __attribute__((ext_vector_type(2)));
typedef unsigned u32x2 __attribute__((ext_vector_type(2)));
#define DI __device__ __forceinline__
#define MFMA32(a, b, c) __builtin_amdgcn_mfma_f32_32x32x16_bf16((a), (b), (c), 0, 0, 0)

constexpr int DM = 1024, MP = 16384, MS = 256, MT = MP + MS, NPROJ = 2816, DFF = 4096, PLE = 256, WIN_LD = 2824;
constexpr float EPS = 1e-6f;
constexpr int C_QM = 0, C_KM = 512, C_VM = 1024, C_OM = 1536, C_QA = 2048, C_KA = 2560, C_VA = 2688;

constexpr size_t MiB = (size_t)1 << 20;
constexpr size_t WS_GATES = 0;
constexpr size_t WS_BAR = 540672;
constexpr size_t WS_NST = 589824;
constexpr size_t WS_DN = WS_NST + 524288;
constexpr size_t WS_CHST = WS_DN + 524288;
constexpr size_t WS_MST = WS_CHST + 8192;
constexpr size_t WS_CNT = WS_MST + 4096;
constexpr size_t WS_WIN = 2 * MiB;
constexpr size_t WS_WOUT = WS_WIN + (size_t)NPROJ * DM * 2;
constexpr size_t WS_WUP = WS_WOUT + 2 * MiB;
constexpr size_t WS_WDOWN = WS_WUP + 8 * MiB;
constexpr size_t WS_WGATE = WS_WDOWN + 8 * MiB;
constexpr size_t WS_WPP = WS_WGATE + 2 * MiB;
constexpr size_t WS_H1 = 28 * MiB;
constexpr size_t WS_PROJ = 60 * MiB + MiB / 2;
constexpr size_t WS_DC = 150 * MiB;
constexpr size_t WS_CT = 214 * MiB;
constexpr size_t WS_PB = 246 * MiB;
constexpr size_t WS_U = WS_PROJ;
constexpr size_t WS_X1B = 191 * MiB;
constexpr size_t WS_PP = WS_PROJ;
constexpr size_t WS_SSQA = 224 * MiB;
constexpr size_t WS_SSQB = 226 * MiB;
static_assert(WS_WPP + (size_t)DM * PLE * 2 <= WS_H1 && WS_H1 + (size_t)MT * DM * 2 <= WS_PROJ && WS_PROJ + (size_t)MT * NPROJ * 2 <= WS_DC, "ws map");
static_assert(WS_U + (size_t)MT * DFF * 2 <= WS_X1B && WS_X1B + (size_t)MT * DM * 2 <= WS_SSQA && WS_PB + (size_t)MT * PLE * 2 <= 256 * MiB && WS_CNT + 32768 <= WS_WIN, "ws map 2");

constexpr size_t O_YP = 0, O_YS = 16777216, O_PK = 17039360, O_PV = 17072128, O_PC = 17104896, O_PN = 17235968, O_PM = 17236992,
                 O_SK = 17237000, O_SV = 17368072, O_SC = 17499144, O_SN = 18023432, O_SM = 18027528;

constexpr int LDS_BYTES = 147456;

struct Params { const float* in[23]; float* out; unsigned char* ws; int ph_lo, ph_hi; };

DI unsigned pk2(float lo, float hi) { f32x2_t v = {lo, hi}; bf16x2_t b = __builtin_convertvector(v, bf16x2_t); return __builtin_bit_cast(unsigned, b); }
DI float bflo(unsigned w) { return __uint_as_float(w << 16); }
DI float bfhi(unsigned w) { return __uint_as_float(w & 0xffff0000u); }
DI float bf2f(bf16 h) { return __uint_as_float((unsigned)h << 16); }
DI float wave_sum(float v) {
#pragma unroll
    for (int o = 1; o < 64; o <<= 1) v += __shfl_xor(v, o);
    return v;
}
DI float wave_max(float v) {
#pragma unroll
    for (int o = 1; o < 64; o <<= 1) v = fmaxf(v, __shfl_xor(v, o));
    return v;
}
DI float wave_scan_add(float v, int lane) {
#pragma unroll
    for (int o = 1; o < 64; o <<= 1) { float t = __shfl_up(v, o); if (lane >= o) v += t; }
    return v;
}
DI float wave_scan_max(float v, int lane) {
#pragma unroll
    for (int o = 1; o < 64; o <<= 1) { float t = __shfl_up(v, o); if (lane >= o) v = fmaxf(v, t); }
    return v;
}
DI unsigned elem8(const u32x4& w, int j) { const unsigned lo = (j & 2) ? w.y : w.x, hi = (j & 2) ? w.w : w.z; const unsigned d = (j & 4) ? hi : lo; return (j & 1) ? (d >> 16) : (d & 0xffffu); }
typedef short v4i16_t __attribute__((ext_vector_type(4)));
DI bf16x8 tr_frag2(const bf16* base, int pitch, int klo, int khi, int n0, int lane) {
    const int blk = (lane >> 4) & 1, q = (lane & 15) >> 2, p = lane & 3;
    const bf16* a0 = base + (klo + q) * pitch + n0 + 16 * blk + 4 * p; const bf16* a1 = base + (khi + q) * pitch + n0 + 16 * blk + 4 * p;
    const v4i16_t lo = __builtin_amdgcn_ds_read_tr16_b64_v4i16((__attribute__((address_space(3))) v4i16_t*)a0);
    const v4i16_t hi = __builtin_amdgcn_ds_read_tr16_b64_v4i16((__attribute__((address_space(3))) v4i16_t*)a1);
    bf16x8 r; r[0] = lo[0]; r[1] = lo[1]; r[2] = lo[2]; r[3] = lo[3]; r[4] = hi[0]; r[5] = hi[1]; r[6] = hi[2]; r[7] = hi[3]; return r;
}
DI bf16x8 tr_frag(const bf16* base, int pitch, int k0, int n0, int lane) { const int h = lane >> 5; return tr_frag2(base, pitch, k0 + 8 * h, k0 + 8 * h + 4, n0, lane); }
DI float sigmoidf_(float x) { return 1.f / (1.f + __expf(-x)); }
DI float dot4(f32x4 a) { return (a.x * a.x + a.y * a.y) + (a.z * a.z + a.w * a.w); }

struct EpiStore {
    static constexpr bool PERM = true, AFTER_DRAIN = false;
    bf16* O; int ldc;
    DI void operator()(const f32x4 (&acc)[2][2][4][2], const pg8::Unit& u, int wr, int wc, int fr, int fq) const {
        const int row0 = u.pm * 256 + wr * 64 + fr, col0 = u.pn * 256 + wc * 32 + 8 * fq;
#pragma unroll
        for (int ai = 0; ai < 2; ++ai)
#pragma unroll
            for (int m = 0; m < 4; ++m) { bf16* rowp = O + (size_t)(row0 + ai * 128 + m * 16) * ldc + col0;
#pragma unroll
                for (int bj = 0; bj < 2; ++bj) { const f32x4 v0 = acc[ai][bj][m][0], v1 = acc[ai][bj][m][1];
                    u32x4 w; w.x = pk2(v0[0], v0[1]); w.y = pk2(v0[2], v0[3]); w.z = pk2(v1[0], v1[1]); w.w = pk2(v1[2], v1[3]);
                    *(u32x4*)(rowp + bj * 128) = w; } }
    }
};
template <bool XBF> struct EpiResid {
    static constexpr bool PERM = true, AFTER_DRAIN = false;
    const float* xp; const bf16* xb; bf16* XB; float* ssq;
    DI void operator()(const f32x4 (&acc)[2][2][4][2], const pg8::Unit& u, int wr, int wc, int fr, int fq) const {
        const int row0 = u.pm * 256 + wr * 64 + fr, col0 = u.pn * 256 + wc * 32 + 8 * fq;
#pragma unroll
        for (int ai = 0; ai < 2; ++ai)
#pragma unroll
            for (int m = 0; m < 4; ++m) { const int row = row0 + ai * 128 + m * 16;
                bf16* bp = XB + (size_t)row * DM + col0; float s = 0.f;
#pragma unroll
                for (int bj = 0; bj < 2; ++bj) { f32x4 r0, r1;
                    if (XBF) { const u32x4 pw = *(const u32x4*)(xb + (size_t)row * DM + col0 + bj * 128);
                        r0 = (f32x4){bflo(pw.x), bfhi(pw.x), bflo(pw.y), bfhi(pw.y)}; r1 = (f32x4){bflo(pw.z), bfhi(pw.z), bflo(pw.w), bfhi(pw.w)}; }
                    else { const float* xin = xp + (size_t)row * DM + col0 + bj * 128; r0 = *(const f32x4*)xin; r1 = *(const f32x4*)(xin + 4); }
                    const f32x4 v0 = acc[ai][bj][m][0] + r0, v1 = acc[ai][bj][m][1] + r1;
                    u32x4 w; w.x = pk2(v0[0], v0[1]); w.y = pk2(v0[2], v0[3]); w.z = pk2(v1[0], v1[1]); w.w = pk2(v1[2], v1[3]);
                    *(u32x4*)(bp + bj * 128) = w; s += dot4(v0) + dot4(v1); }
                s += __shfl_xor(s, 16); s += __shfl_xor(s, 32);
                if (fq == 0) ssq[(size_t)row * 16 + u.pn * 4 + wc] = s; }
    }
};
DI float row_rstd(const float* ssq, int row) {
    const f32x4* sp = (const f32x4*)(ssq + (size_t)row * 16);
    const f32x4 t = (sp[0] + sp[1]) + (sp[2] + sp[3]);
    return rsqrtf(((t.x + t.y) + (t.z + t.w)) * (1.f / DM) + EPS);
}
struct EpiUp {
    static constexpr bool PERM = true, AFTER_DRAIN = false;
    bf16* U; const float* ssq;
    DI void operator()(const f32x4 (&acc)[2][2][4][2], const pg8::Unit& u, int wr, int wc, int fr, int fq) const {
        const int row0 = u.pm * 256 + wr * 64 + fr, col0 = u.pn * 256 + wc * 32 + 8 * fq;
#pragma unroll
        for (int ai = 0; ai < 2; ++ai)
#pragma unroll
            for (int m = 0; m < 4; ++m) { const int row = row0 + ai * 128 + m * 16; const float rs = row_rstd(ssq, row);
                bf16* bp = U + (size_t)row * DFF + col0;
#pragma unroll
                for (int bj = 0; bj < 2; ++bj) { f32x4 v0 = acc[ai][bj][m][0] * rs, v1 = acc[ai][bj][m][1] * rs;
#pragma unroll
                    for (int e = 0; e < 4; ++e) { const float a = fmaxf(v0[e], 0.f), b = fmaxf(v1[e], 0.f); v0[e] = a * a; v1[e] = b * b; }
                    u32x4 w; w.x = pk2(v0[0], v0[1]); w.y = pk2(v0[2], v0[3]); w.z = pk2(v1[0], v1[1]); w.w = pk2(v1[2], v1[3]);
                    *(u32x4*)(bp + bj * 128) = w; } }
    }
};
struct EpiPle {
    static constexpr bool PERM = true, AFTER_DRAIN = false;
    const bf16* X2; const bf16* PP; bf16* X3; const float* ssq_in; float* ssq_out;
    DI void operator()(const f32x4 (&acc)[2][2][4][2], const pg8::Unit& u, int wr, int wc, int fr, int fq) const {
        const int row0 = u.pm * 256 + wr * 64 + fr, col0 = u.pn * 256 + wc * 32 + 8 * fq;
#pragma unroll
        for (int ai = 0; ai < 2; ++ai)
#pragma unroll
            for (int m = 0; m < 4; ++m) { const int row = row0 + ai * 128 + m * 16; const float rs = row_rstd(ssq_in, row);
                const size_t off = (size_t)row * DM + col0; float s = 0.f;
#pragma unroll
                for (int bj = 0; bj < 2; ++bj) { const u32x4 xw = *(const u32x4*)(X2 + off + bj * 128), pw = *(const u32x4*)(PP + off + bj * 128);
                    const f32x4 r0 = {bflo(xw.x), bfhi(xw.x), bflo(xw.y), bfhi(xw.y)}, r1 = {bflo(xw.z), bfhi(xw.z), bflo(xw.w), bfhi(xw.w)};
                    const f32x4 p0 = {bflo(pw.x), bfhi(pw.x), bflo(pw.y), bfhi(pw.y)}, p1 = {bflo(pw.z), bfhi(pw.z), bflo(pw.w), bfhi(pw.w)};
                    f32x4 v0, v1;
#pragma unroll
                    for (int e = 0; e < 4; ++e) { v0[e] = r0[e] + sigmoidf_(acc[ai][bj][m][0][e] * rs) * p0[e]; v1[e] = r1[e] + sigmoidf_(acc[ai][bj][m][1][e] * rs) * p1[e]; }
                    u32x4 w; w.x = pk2(v0[0], v0[1]); w.y = pk2(v0[2], v0[3]); w.z = pk2(v1[0], v1[1]); w.w = pk2(v1[2], v1[3]);
                    *(u32x4*)(X3 + off + bj * 128) = w; s += dot4(v0) + dot4(v1); }
                s += __shfl_xor(s, 16); s += __shfl_xor(s, 32);
                if (fq == 0) ssq_out[(size_t)row * 16 + u.pn * 4 + wc] = s; }
    }
};


struct EpiPleNorm {
    static constexpr bool PERM = true, AFTER_DRAIN = false;
    const bf16* X2; const bf16* PP; float* out; const float* ssq_in; float* ssq_out; unsigned* cnt; const float* gf;
    DI void operator()(f32x4 (&acc)[2][2][4][2], const pg8::Unit& u, int wr, int wc, int fr, int fq) const {
        const int row0 = u.pm * 256 + wr * 64 + fr, col0 = u.pn * 256 + wc * 32 + 8 * fq;
#pragma unroll
        for (int ai = 0; ai < 2; ++ai)
#pragma unroll
            for (int m = 0; m < 4; ++m) { const int row = row0 + ai * 128 + m * 16; const float rs = row_rstd(ssq_in, row);
                const size_t off = (size_t)row * DM + col0; float s = 0.f;
#pragma unroll
                for (int bj = 0; bj < 2; ++bj) { const u32x4 xw = *(const u32x4*)(X2 + off + bj * 128), pw = *(const u32x4*)(PP + off + bj * 128);
                    const f32x4 r0 = {bflo(xw.x), bfhi(xw.x), bflo(xw.y), bfhi(xw.y)}, r1 = {bflo(xw.z), bfhi(xw.z), bflo(xw.w), bfhi(xw.w)};
                    const f32x4 p0 = {bflo(pw.x), bfhi(pw.x), bflo(pw.y), bfhi(pw.y)}, p1 = {bflo(pw.z), bfhi(pw.z), bflo(pw.w), bfhi(pw.w)};
                    f32x4 v0, v1;
#pragma unroll
                    for (int e = 0; e < 4; ++e) { v0[e] = r0[e] + sigmoidf_(acc[ai][bj][m][0][e] * rs) * p0[e]; v1[e] = r1[e] + sigmoidf_(acc[ai][bj][m][1][e] * rs) * p1[e]; }
                    acc[ai][bj][m][0] = v0; acc[ai][bj][m][1] = v1; s += dot4(v0) + dot4(v1); }
                s += __shfl_xor(s, 16); s += __shfl_xor(s, 32);
                if (fq == 0) __hip_atomic_store(ssq_out + (size_t)row * 16 + u.pn * 4 + wc, s, __ATOMIC_RELAXED, __HIP_MEMORY_SCOPE_AGENT); }
        asm volatile("s_waitcnt vmcnt(0)" ::: "memory");
        unsigned* c = cnt + 64 * u.pm;
        if ((threadIdx.x & 63) == 0) (void)__hip_atomic_fetch_add(c, 1u, __ATOMIC_RELAXED, __HIP_MEMORY_SCOPE_AGENT);
        { unsigned sp = 0; while (__hip_atomic_load(c, __ATOMIC_RELAXED, __HIP_MEMORY_SCOPE_AGENT) < 32u) { __builtin_amdgcn_s_sleep(2); if (++sp > (1u << 22)) break; } }
        asm volatile("" ::: "memory");
#pragma unroll
        for (int ai = 0; ai < 2; ++ai)
#pragma unroll
            for (int m = 0; m < 4; ++m) { const int row = row0 + ai * 128 + m * 16;
                const unsigned* sp4 = (const unsigned*)(ssq_out + (size_t)row * 16 + fq * 4);
                float t = (__uint_as_float(__hip_atomic_load(sp4, __ATOMIC_RELAXED, __HIP_MEMORY_SCOPE_AGENT)) + __uint_as_float(__hip_atomic_load(sp4 + 1, __ATOMIC_RELAXED, __HIP_MEMORY_SCOPE_AGENT)))
                        + (__uint_as_float(__hip_atomic_load(sp4 + 2, __ATOMIC_RELAXED, __HIP_MEMORY_SCOPE_AGENT)) + __uint_as_float(__hip_atomic_load(sp4 + 3, __ATOMIC_RELAXED, __HIP_MEMORY_SCOPE_AGENT)));
                t += __shfl_xor(t, 16); t += __shfl_xor(t, 32);
                const float rs = rsqrtf(t * (1.f / DM) + EPS);
                float* op = out + (size_t)row * DM + col0;
#pragma unroll
                for (int bj = 0; bj < 2; ++bj) { const f32x4 g0 = *(const f32x4*)(gf + col0 + bj * 128), g1 = *(const f32x4*)(gf + col0 + bj * 128 + 4);
                    *(f32x4*)(op + bj * 128) = acc[ai][bj][m][0] * rs * g0; *(f32x4*)(op + bj * 128 + 4) = acc[ai][bj][m][1] * rs * g1; } }
    }
};

struct SEpiStore { bf16* O; int ldc;
    DI void operator()(int row, int col, f32x4 v, int ct) const { u32x2 w; w.x = pk2(v.x, v.y); w.y = pk2(v.z, v.w); *(u32x2*)(O + (size_t)row * ldc + col) = w; } };
template <bool XBF> struct SEpiResid { const float* xs; const bf16* xb; bf16* XB; float* ssq;
    DI void operator()(int row, int col, f32x4 v, int ct) const {
        if (XBF) { const u32x2 pw = *(const u32x2*)(xb + (size_t)row * DM + col); v = v + (f32x4){bflo(pw.x), bfhi(pw.x), bflo(pw.y), bfhi(pw.y)}; }
        else v = v + *(const f32x4*)(xs + (size_t)(row - MP) * DM + col);
        u32x2 w; w.x = pk2(v.x, v.y); w.y = pk2(v.z, v.w); *(u32x2*)(XB + (size_t)row * DM + col) = w;
        float s = dot4(v); s += __shfl_xor(s, 1); s += __shfl_xor(s, 2); s += __shfl_xor(s, 4); s += __shfl_xor(s, 8);
        if ((threadIdx.x & 15) == 0) ssq[(size_t)row * 16 + ct] = s; } };
struct SEpiUp { bf16* U; const float* ssq;
    DI void operator()(int row, int col, f32x4 v, int ct) const { const float rs = row_rstd(ssq, row);
#pragma unroll
        for (int e = 0; e < 4; ++e) { const float a = fmaxf(v[e] * rs, 0.f); v[e] = a * a; }
        u32x2 w; w.x = pk2(v.x, v.y); w.y = pk2(v.z, v.w); *(u32x2*)(U + (size_t)row * DFF + col) = w; } };
struct SEpiPle { const bf16* X2; const bf16* PP; bf16* X3; const float* ssq_in; float* ssq_out;
    DI void operator()(int row, int col, f32x4 v, int ct) const { const float rs = row_rstd(ssq_in, row);
        const size_t off = (size_t)row * DM + col; const u32x2 xw = *(const u32x2*)(X2 + off), pw = *(const u32x2*)(PP + off);
        const f32x4 r = {bflo(xw.x), bfhi(xw.x), bflo(xw.y), bfhi(xw.y)}, pp = {bflo(pw.x), bfhi(pw.x), bflo(pw.y), bfhi(pw.y)}; f32x4 o;
#pragma unroll
        for (int e = 0; e < 4; ++e) o[e] = r[e] + sigmoidf_(v[e] * rs) * pp[e];
        __hip_atomic_store((unsigned long long*)(X3 + off), (unsigned long long)pk2(o.x, o.y) | ((unsigned long long)pk2(o.z, o.w) << 32), __ATOMIC_RELAXED, __HIP_MEMORY_SCOPE_AGENT);
        float s = dot4(o); s += __shfl_xor(s, 1); s += __shfl_xor(s, 2); s += __shfl_xor(s, 4); s += __shfl_xor(s, 8);
        if ((threadIdx.x & 15) == 0) __hip_atomic_store(ssq_out + (size_t)row * 16 + ct, s, __ATOMIC_RELAXED, __HIP_MEMORY_SCOPE_AGENT); } };
template <int K, class Epi, bool FINAL = false> DI void small_gemm(const bf16* A, const bf16* Bt, int N, unsigned char* lds, int bid, int G, const Epi& E, unsigned* cnt = nullptr, const float* gf = nullptr, float* yout = nullptr) {
    const int tid = threadIdx.x, lane = tid & 63, wave = tid >> 6, ql = lane & 31, half = lane >> 5;
    float* red = (float*)lds;
    constexpr int KW = K / 8, CH = KW >= 128 ? 128 : KW, NS = CH / 16;
    const int ntiles = 8 * (N / 64);
    for (int t = bid; t < ntiles; t += G) {
        const int rt = t & 7, ct = t >> 3;
        const bf16* ap = A + (size_t)(MP + rt * 32 + ql) * K + wave * KW + half * 8;
        const bf16* bp0 = Bt + (size_t)(ct * 64 + ql) * K + wave * KW + half * 8; const bf16* bp1 = bp0 + (size_t)32 * K;
        f32x16 c0, c1;
#pragma unroll
        for (int r = 0; r < 16; ++r) { c0[r] = 0.f; c1[r] = 0.f; }
#pragma unroll 1
        for (int k = 0; k < KW; k += CH) {
            bf16x8 a[NS], b0[NS], b1[NS];
#pragma unroll
            for (int i = 0; i < NS; ++i) { a[i] = *(const bf16x8*)(ap + k + 16 * i); b0[i] = *(const bf16x8*)(bp0 + k + 16 * i); b1[i] = *(const bf16x8*)(bp1 + k + 16 * i); }
#pragma unroll
            for (int i = 0; i < NS; ++i) { c0 = MFMA32(a[i], b0[i], c0); c1 = MFMA32(a[i], b1[i], c1); } }
#pragma unroll
        for (int r = 0; r < 16; ++r) { red[((wave * 2 + 0) * 16 + r) * 64 + lane] = c0[r]; red[((wave * 2 + 1) * 16 + r) * 64 + lane] = c1[r]; }
        __syncthreads();
        { const int row = tid >> 4, col = (tid & 15) * 4, j = col >> 5, cq = col & 31, hh = (row >> 2) & 1, r = (row & 3) + 4 * (row >> 3);
          f32x4 v = {0.f, 0.f, 0.f, 0.f};
#pragma unroll
          for (int w = 0; w < 8; ++w) v = v + *(const f32x4*)(red + ((w * 2 + j) * 16 + r) * 64 + hh * 32 + cq);
          E(MP + rt * 32 + row, ct * 64 + col, v, ct); }
        if constexpr (FINAL) {
            asm volatile("s_waitcnt vmcnt(0)" ::: "memory");
            __syncthreads();
            unsigned* flag = (unsigned*)(lds + 65536);
            if (tid == 0) *flag = __hip_atomic_fetch_add(cnt + 64 * (64 + rt), 1u, __ATOMIC_RELAXED, __HIP_MEMORY_SCOPE_AGENT);
            __syncthreads();
            if (*flag == 15u) {
                __builtin_amdgcn_fence(__ATOMIC_ACQUIRE, "agent");
                asm volatile("s_waitcnt vmcnt(0)" ::: "memory");
#pragma unroll 1
                for (int rr = 0; rr < 4; ++rr) { const int row = MP + rt * 32 + wave * 4 + rr; const float rs = row_rstd(E.ssq_out, row);
#pragma unroll
                    for (int j = 0; j < 2; ++j) { const u32x4 xw = *(const u32x4*)(E.X3 + (size_t)row * DM + lane * 8 + 512 * j);
                        const f32x4 g0 = *(const f32x4*)(gf + lane * 8 + 512 * j), g1 = *(const f32x4*)(gf + lane * 8 + 512 * j + 4);
                        *(f32x4*)(yout + (size_t)row * DM + lane * 8 + 512 * j) = (f32x4){bflo(xw.x), bfhi(xw.x), bflo(xw.y), bfhi(xw.y)} * rs * g0;
                        *(f32x4*)(yout + (size_t)row * DM + lane * 8 + 512 * j + 4) = (f32x4){bflo(xw.z), bfhi(xw.z), bflo(xw.w), bfhi(xw.w)} * rs * g1; } } }
        }
        __syncthreads();
    }
}

DI void tr_item(const float* W, int ldw, int K, bf16* Wt, const float* gk, int k0, int n0, int nsrc0, float nsc, float* tt, int tid) {
    f32x4 v[4][2]; float g[2];
#pragma unroll
    for (int i = 0; i < 2; ++i) { const int kk = (tid >> 4) + 32 * i, c4 = (tid & 15) * 4;
#pragma unroll
        for (int sub = 0; sub < 4; ++sub) v[sub][i] = *(const f32x4*)(W + (size_t)(k0 + kk) * ldw + nsrc0 + sub * 64 + c4);
        g[i] = (gk ? gk[k0 + kk] : 1.f) * nsc; }
#pragma unroll
    for (int i = 0; i < 2; ++i) { const int kk = (tid >> 4) + 32 * i, c4 = (tid & 15) * 4;
#pragma unroll
        for (int sub = 0; sub < 4; ++sub) { float* d = tt + sub * 4160 + kk * 65 + c4; d[0] = v[sub][i].x * g[i]; d[1] = v[sub][i].y * g[i]; d[2] = v[sub][i].z * g[i]; d[3] = v[sub][i].w * g[i]; } }
    __syncthreads();
    { const int n = tid >> 3, kc = (tid & 7) * 8;
#pragma unroll
      for (int sub = 0; sub < 4; ++sub) { const float* s = tt + sub * 4160 + kc * 65 + n;
          u32x4 o; o.x = pk2(s[0], s[65]); o.y = pk2(s[2 * 65], s[3 * 65]); o.z = pk2(s[4 * 65], s[5 * 65]); o.w = pk2(s[6 * 65], s[7 * 65]);
          *(u32x4*)(Wt + (size_t)(n0 + sub * 64 + n) * K + k0 + kc) = o; } }
    __syncthreads();
}
DI void phase0(const Params& P, unsigned char* lds, int bid, int G) {
    const int tid = threadIdx.x, lane = tid & 63, wave = tid >> 6;
    float* wgT = (float*)lds;
    float* tt = (float*)(lds + 32768);
    unsigned char* ws = P.ws;
    const float* w_in = P.in[10];
    for (int k = tid; k < DM; k += 512) {
        const f32x4 a = *(const f32x4*)(w_in + (size_t)k * WIN_LD + 2048), b = *(const f32x4*)(w_in + (size_t)k * WIN_LD + 2052);
        wgT[k] = a.x; wgT[1024 + k] = a.y; wgT[2048 + k] = a.z; wgT[3072 + k] = a.w;
        wgT[4096 + k] = b.x; wgT[5120 + k] = b.y; wgT[6144 + k] = b.z; wgT[7168 + k] = b.w; }
    __syncthreads();
    constexpr int T_IN = 16 * 11, T_OUT = 16 * 4, T_UP = 16 * 16, T_DOWN = 64 * 4, T_GATE = 16 * 4, T_PP = 4 * 4;
    constexpr int T_ALL = T_IN + T_OUT + T_UP + T_DOWN + T_GATE + T_PP;
    for (int it = bid; it < T_ALL; it += G) {
        int r = it;
        if (r < T_IN) { const int kb = r / 11, nb = r % 11, n0 = nb * 256;
            const float nsc = (n0 >= C_KM && n0 < C_VM) ? 0.08838834764831845f : ((n0 >= C_QA && n0 < C_KA) ? 0.125f : 1.f);
            tr_item(w_in, WIN_LD, DM, (bf16*)(ws + WS_WIN), nullptr, kb * 64, n0, n0 + (n0 >= 2048 ? 8 : 0), nsc, tt, tid); continue; } r -= T_IN;
        if (r < T_OUT) { tr_item(P.in[15], DM, DM, (bf16*)(ws + WS_WOUT), nullptr, (r / 4) * 64, (r % 4) * 256, (r % 4) * 256, 1.f, tt, tid); continue; } r -= T_OUT;
        if (r < T_UP) { tr_item(P.in[17], DFF, DM, (bf16*)(ws + WS_WUP), P.in[16], (r / 16) * 64, (r % 16) * 256, (r % 16) * 256, 1.f, tt, tid); continue; } r -= T_UP;
        if (r < T_DOWN) { tr_item(P.in[18], DM, DFF, (bf16*)(ws + WS_WDOWN), nullptr, (r / 4) * 64, (r % 4) * 256, (r % 4) * 256, 1.f, tt, tid); continue; } r -= T_DOWN;
        if (r < T_GATE) { tr_item(P.in[20], DM, DM, (bf16*)(ws + WS_WGATE), P.in[19], (r / 4) * 64, (r % 4) * 256, (r % 4) * 256, 1.f, tt, tid); continue; } r -= T_GATE;
        tr_item(P.in[21], DM, PLE, (bf16*)(ws + WS_WPP), nullptr, (r / 4) * 64, (r % 4) * 256, (r % 4) * 256, 1.f, tt, tid);
    }
    const float* g_mix = P.in[9]; bf16* H1 = (bf16*)(ws + WS_H1); float* GT = (float*)(ws + WS_GATES);
    const f32x4 bi = *(const f32x4*)P.in[11], bf_ = *(const f32x4*)P.in[12];
    for (int it = G - 1 - bid; it < MT / 16; it += G) {
        f32x4 vv[2][4];
#pragma unroll
        for (int rr = 0; rr < 2; ++rr) { const int row = it * 16 + rr * 8 + wave;
            const float* xr = row < MP ? P.in[0] + (size_t)row * DM : P.in[1] + (size_t)(row - MP) * DM;
#pragma unroll
            for (int j = 0; j < 4; ++j) vv[rr][j] = *(const f32x4*)(xr + lane * 4 + 256 * j); }
#pragma unroll
        for (int rr = 0; rr < 2; ++rr) { const int row = it * 16 + rr * 8 + wave; float s = 0.f;
#pragma unroll
        for (int j = 0; j < 4; ++j) s += dot4(vv[rr][j]);
        const float rstd = rsqrtf(wave_sum(s) * (1.f / DM) + EPS);
        float ga[8];
#pragma unroll
        for (int c = 0; c < 8; ++c) ga[c] = 0.f;
#pragma unroll
        for (int j = 0; j < 4; ++j) { const f32x4 g = *(const f32x4*)(g_mix + lane * 4 + 256 * j);
            f32x4 h = vv[rr][j] * rstd * g;
            u32x2 o; o.x = pk2(h.x, h.y); o.y = pk2(h.z, h.w);
            *(u32x2*)(H1 + (size_t)row * DM + lane * 4 + 256 * j) = o;
#pragma unroll
            for (int c = 0; c < 8; ++c) { const f32x4 w = *(const f32x4*)(wgT + c * 1024 + lane * 4 + 256 * j); ga[c] += (h.x * w.x + h.y * w.y) + (h.z * w.z + h.w * w.w); } }
#pragma unroll
        for (int c = 0; c < 8; ++c) ga[c] = wave_sum(ga[c]);
        if (lane == 0) {
            f32x4 iv = {ga[0] + bi.x, ga[1] + bi.y, ga[2] + bi.z, ga[3] + bi.w};
            f32x4 fv = {ga[4] + bf_.x, ga[5] + bf_.y, ga[6] + bf_.z, ga[7] + bf_.w};
#pragma unroll
            for (int e = 0; e < 4; ++e) fv[e] = fminf(fv[e], 0.f) - log1pf(__expf(-fabsf(fv[e])));
            *(f32x4*)(GT + (size_t)row * 8) = iv; *(f32x4*)(GT + (size_t)row * 8 + 4) = fv; } }
    }
    bf16* PB = (bf16*)(ws + WS_PB);
    for (int it = G - 1 - bid; it < MT * PLE / 4096; it += G) {
        const size_t e = (size_t)it * 4096 + tid * 8;
        const float* src = e < (size_t)MP * PLE ? P.in[7] + e : P.in[8] + (e - (size_t)MP * PLE);
        const f32x4 a = *(const f32x4*)src, b = *(const f32x4*)(src + 4);
        u32x4 o; o.x = pk2(a.x, a.y); o.y = pk2(a.z, a.w); o.z = pk2(b.x, b.y); o.w = pk2(b.z, b.w);
        *(u32x4*)(PB + e) = o;
    }
}

DI void dc_item(const Params& P, unsigned char* lds, int it) {
    const int tid = threadIdx.x, lane = tid & 63, wave = tid >> 6, ql = lane & 31, half = lane >> 5;
    constexpr int PT = 160;
    bf16* sV = (bf16*)lds; bf16* sKw = (bf16*)(lds + 20480); float* sw = (float*)(lds + 40960);
    const int cid = it >> 2, h = it & 3, rowbase = cid * 64;
    const bf16* PROJ = (const bf16*)(P.ws + WS_PROJ); const float* GT = (const float*)(P.ws + WS_GATES);
    if (wave == 0) {
        const float iv = GT[(size_t)(rowbase + lane) * 8 + h], lf = GT[(size_t)(rowbase + lane) * 8 + 4 + h];
        const float b = wave_scan_add(lf, lane), B = __shfl(b, 63), e = iv - b, emax = wave_max(e);
        sw[lane] = __expf(e - emax);
        if (lane == 0) { float* CH = (float*)(P.ws + WS_CHST); CH[it * 2] = B; CH[it * 2 + 1] = B + emax; }
    }
    u32x4 kr[2], vr[2];
#pragma unroll
    for (int j = 0; j < 2; ++j) { const int idx = tid + 512 * j, s = idx >> 4, dg = idx & 15;
        const bf16* src = PROJ + (size_t)(rowbase + s) * NPROJ + h * 128 + dg * 8;
        kr[j] = *(const u32x4*)(src + C_KM); vr[j] = *(const u32x4*)(src + C_VM); }
    __syncthreads();
#pragma unroll
    for (int j = 0; j < 2; ++j) { const int idx = tid + 512 * j, s = idx >> 4, dg = idx & 15; const float w = sw[s];
        u32x4 kw;
#pragma unroll
        for (int e = 0; e < 4; ++e) kw[e] = pk2(bflo(kr[j][e]) * w, bfhi(kr[j][e]) * w);
        *(u32x4*)(sKw + s * PT + dg * 8) = kw; *(u32x4*)(sV + s * PT + dg * 8) = vr[j]; }
    __syncthreads();
    const int vt = wave >> 1, dt0 = 2 * (wave & 1);
    f32x16 acc[2];
#pragma unroll
    for (int q = 0; q < 2; ++q)
#pragma unroll
        for (int r = 0; r < 16; ++r) acc[q][r] = 0.f;
#pragma unroll
    for (int kk = 0; kk < 4; ++kk) { const bf16x8 a = tr_frag(sV, PT, kk * 16, vt * 32, lane);
#pragma unroll
        for (int q = 0; q < 2; ++q) { const bf16x8 b = tr_frag(sKw, PT, kk * 16, (dt0 + q) * 32, lane); acc[q] = MFMA32(a, b, acc[q]); } }
    bf16* DC = (bf16*)(P.ws + WS_DC) + (size_t)it * 16384;
#pragma unroll
    for (int q = 0; q < 2; ++q)
#pragma unroll
        for (int r = 0; r < 16; ++r) { const int v = vt * 32 + 8 * (r >> 2) + 4 * half + (r & 3), d = (dt0 + q) * 32 + ql; DC[v * 128 + d] = (bf16)(pk2(acc[q][r], 0.f) & 0xffffu); }
    if (tid < 128) { float s = 0.f;
#pragma unroll 8
        for (int k = 0; k < 64; ++k) s += bf2f(sKw[k * PT + tid]);
        ((float*)(P.ws + WS_DN))[(size_t)it * 128 + tid] = s; }
    __syncthreads();
}

template <bool SAMPLE> DI void attn_item(const Params& P, unsigned char* lds, int item) {
    constexpr int NKT = SAMPLE ? 5 : 6, NK = NKT * 32, VP = 96;
    const int tid = threadIdx.x, lane = tid & 63, wave = tid >> 6, ql = lane & 31, half = lane >> 5;
    bf16* sK = (bf16*)lds;
    bf16* sV = (bf16*)(lds + 27648);
    const bf16* PROJ = (const bf16*)(P.ws + WS_PROJ); bf16* MIX = (bf16*)(P.ws + WS_H1);
    int b, n, kvh;
    if (SAMPLE) { b = item >> 1; kvh = item & 1; n = 0; } else { kvh = item & 1; n = (item >> 1) & 127; b = item >> 8; }
    { u32x4 kq[3], vq[3];
#pragma unroll
      for (int i = 0; i < 3; ++i) { const int c = tid + 512 * i, hi = c >> 8, dg = (c & 3) | ((hi & 1) << 2), s = (hi >> 1) * 64 + ((c >> 2) & 63);
        u32x4 kv = {0u, 0u, 0u, 0u}, vv = {0u, 0u, 0u, 0u};
        if (s < NK) {
        if (SAMPLE) {
            if (s < 128) { const float* ck = P.in[2] + ((size_t)(b * 128 + s) * 2 + kvh) * 64 + dg * 8; const float* cv = P.in[3] + ((size_t)(b * 128 + s) * 2 + kvh) * 64 + dg * 8;
                const f32x4 a0 = *(const f32x4*)ck, a1 = *(const f32x4*)(ck + 4), b0 = *(const f32x4*)cv, b1 = *(const f32x4*)(cv + 4);
                kv.x = pk2(a0.x, a0.y); kv.y = pk2(a0.z, a0.w); kv.z = pk2(a1.x, a1.y); kv.w = pk2(a1.z, a1.w);
                vv.x = pk2(b0.x, b0.y); vv.y = pk2(b0.z, b0.w); vv.z = pk2(b1.x, b1.y); vv.w = pk2(b1.z, b1.w); }
            else { const bf16* src = PROJ + (size_t)(MP + b * 32 + s - 128) * NPROJ + kvh * 64 + dg * 8; kv = *(const u32x4*)(src + C_KA); vv = *(const u32x4*)(src + C_VA); }
        } else { const int tok = 64 * (n - 2) + s;
            if (tok >= 0) { const bf16* src = PROJ + (size_t)(b * 8192 + tok) * NPROJ + kvh * 64 + dg * 8; kv = *(const u32x4*)(src + C_KA); vv = *(const u32x4*)(src + C_VA); } } }
        kq[i] = kv; vq[i] = vv; }
#pragma unroll
      for (int i = 0; i < 3; ++i) { const int c = tid + 512 * i, hi = c >> 8, dgl = c & 3, dg = dgl | ((hi & 1) << 2), s = (hi >> 1) * 64 + ((c >> 2) & 63);
        if (s < NK) { *(u32x4*)(sK + s * 72 + dg * 8) = kq[i]; *(u32x4*)(sV + s * VP + dg * 8) = vq[i]; } } }
    __syncthreads();
    int g, qoff; bool active;
    if (SAMPLE) { g = wave & 3; qoff = 0; active = wave < 4; } else { g = wave >> 1; qoff = 32 * (wave & 1); active = true; }
    if (active) {
        const int qrow = (SAMPLE ? MP + b * 32 : b * 8192 + n * 64) + qoff + ql, head = kvh * 4 + g;
        bf16x8 qf[4];
#pragma unroll
        for (int kk = 0; kk < 4; ++kk) qf[kk] = *(const bf16x8*)(PROJ + (size_t)qrow * NPROJ + C_QA + head * 64 + kk * 16 + half * 8);
        const float slope = exp2f(-(float)(head + 1)), sink = P.in[14][head];
        const int q = qoff + ql, smin = SAMPLE ? 0 : 64 * (2 - n);
        float m_run = sink, den = 0.f;
        f32x16 o[2];
#pragma unroll
        for (int vt = 0; vt < 2; ++vt)
#pragma unroll
            for (int r = 0; r < 16; ++r) o[vt][r] = 0.f;
#pragma unroll 1
        for (int st = 0; st < NKT; ++st) {
            if (st * 32 + 32 <= smin) continue;
            f32x16 sc;
#pragma unroll
            for (int r = 0; r < 16; ++r) sc[r] = 0.f;
#pragma unroll
            for (int kk = 0; kk < 4; ++kk) { const bf16x8 a = *(const bf16x8*)(sK + (st * 32 + ql) * 72 + kk * 16 + half * 8); sc = MFMA32(a, qf[kk], sc); }
            float tm = -INFINITY;
#pragma unroll
            for (int r = 0; r < 16; ++r) { const int s = st * 32 + 8 * (r >> 2) + 4 * half + (r & 3);
                float v = sc[r] - slope * fabsf((float)(128 + q - s)); if (s < smin) v = -INFINITY; sc[r] = v; tm = fmaxf(tm, v); }
            tm = fmaxf(tm, __shfl_xor(tm, 32));
            const float m_new = fmaxf(m_run, tm), alpha = __expf(m_run - m_new); m_run = m_new;
            den *= alpha;
#pragma unroll
            for (int r = 0; r < 16; ++r) { const float p = __expf(sc[r] - m_new); sc[r] = p; den += p; }
#pragma unroll
            for (int vt = 0; vt < 2; ++vt)
#pragma unroll
                for (int r = 0; r < 16; ++r) o[vt][r] *= alpha;
#pragma unroll
            for (int k2 = 0; k2 < 2; ++k2) { u32x4 pw; pw.x = pk2(sc[8 * k2], sc[8 * k2 + 1]); pw.y = pk2(sc[8 * k2 + 2], sc[8 * k2 + 3]);
                pw.z = pk2(sc[8 * k2 + 4], sc[8 * k2 + 5]); pw.w = pk2(sc[8 * k2 + 6], sc[8 * k2 + 7]);
                const bf16x8 bfr = __builtin_bit_cast(bf16x8, pw);
#pragma unroll
                for (int vt = 0; vt < 2; ++vt) { const int klo = st * 32 + k2 * 16 + 4 * half;
                    o[vt] = MFMA32(tr_frag2(sV, VP, klo, klo + 8, vt * 32, lane), bfr, o[vt]); } }
        }
        den += __shfl_xor(den, 32); den += __expf(sink - m_run);
        const float inv = 1.f / den;
        bf16* orow = MIX + (size_t)qrow * DM + 512 + head * 64;
#pragma unroll
        for (int vt = 0; vt < 2; ++vt)
#pragma unroll
            for (int g4 = 0; g4 < 4; ++g4) { u32x2 w; w.x = pk2(o[vt][4 * g4] * inv, o[vt][4 * g4 + 1] * inv); w.y = pk2(o[vt][4 * g4 + 2] * inv, o[vt][4 * g4 + 3] * inv);
                *(u32x2*)(orow + vt * 32 + 8 * g4 + 4 * half) = w; }
    }
    __syncthreads();
}

DI void kvcopy_item(const Params& P, int item) {
    const int e = item * 2048 + threadIdx.x * 4;
    const bf16* PROJ = (const bf16*)(P.ws + WS_PROJ);
    f32x4 v;
    if (e < 65536) { const int isv = e >> 15, idx = e & 32767, b = idx >> 14, w = (idx >> 7) & 127, c = idx & 127;
        const u32x2 pw = *(const u32x2*)(PROJ + (size_t)(b * 8192 + 8064 + w) * NPROJ + (isv ? C_VA : C_KA) + c);
        v = (f32x4){bflo(pw.x), bfhi(pw.x), bflo(pw.y), bfhi(pw.y)};
        *(f32x4*)(P.out + (isv ? O_PV : O_PK) + idx) = v;
    } else { const int e2 = e - 65536, isv = e2 >> 17, idx = e2 & 131071, b = idx >> 14, w = (idx >> 7) & 127, c = idx & 127;
        if (w < 96) v = *(const f32x4*)(P.in[isv ? 3 : 2] + (size_t)(b * 128 + w + 32) * 128 + c);
        else { const u32x2 pw = *(const u32x2*)(PROJ + (size_t)(MP + b * 32 + w - 96) * NPROJ + (isv ? C_VA : C_KA) + c); v = (f32x4){bflo(pw.x), bfhi(pw.x), bflo(pw.y), bfhi(pw.y)}; }
        *(f32x4*)(P.out + (isv ? O_SV : O_SK) + idx) = v; }
}

DI void scan_item(const Params& P, unsigned char* lds, int it) {
    const int tid = threadIdx.x;
    float* sB = (float*)lds; float* sM = sB + 128; float* wc = sB + 256; float* wsc = sB + 384;
    const int bh = it >> 5, part = it & 31, b = bh >> 2, h = bh & 3;
    const float* CH = (const float*)(P.ws + WS_CHST);
    if (tid < 128) { const int item = (b * 128 + tid) * 4 + h; sB[tid] = CH[item * 2]; sM[tid] = CH[item * 2 + 1]; }
    __syncthreads();
    if (tid < 64) {
        const int l = tid; const float B0 = sB[2 * l], M0 = sM[2 * l], B1 = sB[2 * l + 1], M1 = sM[2 * l + 1];
        float cb = B0 + B1, cm = fmaxf(M0 + B1, M1);
#pragma unroll
        for (int o = 1; o < 64; o <<= 1) { const float tb = __shfl_up(cb, o), tm = __shfl_up(cm, o); if (l >= o) { cm = fmaxf(tm + cb, cm); cb = tb + cb; } }
        float xb = __shfl_up(cb, 1), xm = __shfl_up(cm, 1); if (l == 0) { xb = 0.f; xm = -INFINITY; }
        const float ms0 = fmaxf(xb, xm);
        const float ma0 = fmaxf(ms0 + B0, M0), ma1 = fmaxf(ma0 + B1, M1);
        wc[2 * l] = __expf(B0 + ms0 - ma0); wsc[2 * l] = __expf(M0 - ma0); wc[2 * l + 1] = __expf(B1 + ma0 - ma1); wsc[2 * l + 1] = __expf(M1 - ma1);
        if (part == 0) { float* MST = (float*)(P.ws + WS_MST); MST[(b * 128 + 2 * l) * 4 + h] = ms0; MST[(b * 128 + 2 * l + 1) * 4 + h] = ma0;
            if (l == 63) P.out[O_PM + b * 4 + h] = ma1; } }
    __syncthreads();
    const int idx = part * 512 + tid;
    const bf16* DC = (const bf16*)(P.ws + WS_DC) + ((size_t)(b * 128) * 4 + h) * 16384 + idx;
    bf16* CT = (bf16*)(P.ws + WS_CT) + ((size_t)(b * 128) * 4 + h) * 16384 + idx;
    float C = 0.f;
    { float d[32], dn[32], e[32], en[32];
      const bool nthr = tid < 4; const int ne = part * 4 + (tid & 3);
      const float* __restrict__ DN = (const float*)(P.ws + WS_DN) + ((size_t)(b * 128) * 4 + h) * 128 + ne;
      float* __restrict__ NST = (float*)(P.ws + WS_NST) + ((size_t)(b * 128) * 4 + h) * 128 + ne; float nn = 0.f;
#pragma unroll
      for (int j = 0; j < 32; ++j) { d[j] = bf2f(DC[(size_t)j * 65536]); e[j] = nthr ? DN[(size_t)j * 512] : 0.f; }
#pragma unroll 1
      for (int n0 = 0; n0 < 128; n0 += 32) {
          if (n0 + 32 < 128) {
#pragma unroll
              for (int j = 0; j < 32; ++j) { dn[j] = bf2f(DC[(size_t)(n0 + 32 + j) * 65536]); en[j] = nthr ? DN[(size_t)(n0 + 32 + j) * 512] : 0.f; } }
#pragma unroll
          for (int j = 0; j < 32; ++j) { const float w1 = wc[n0 + j], w2 = wsc[n0 + j];
              CT[(size_t)(n0 + j) * 65536] = (bf16)(pk2(C, 0.f) & 0xffffu); C = w1 * C + w2 * d[j];
              if (nthr) NST[(size_t)(n0 + j) * 512] = nn; nn = w1 * nn + w2 * e[j]; }
#pragma unroll
          for (int j = 0; j < 32; ++j) { d[j] = dn[j]; e[j] = en[j]; } }
      if (nthr) P.out[O_PN + (b * 4 + h) * 128 + ne] = nn; }
    { const int v = idx >> 7, d = idx & 127; P.out[O_PC + ((size_t)(b * 4 + h) * 128 + d) * 128 + v] = C; }
    __syncthreads();
}

struct MlR { u32x4 q[2], k[2], v[2], ct[4], om[2]; float nv, gi, glf, mn; };
DI void ml_load(const Params& P, int it, MlR& R) {
    const int tid = threadIdx.x, lane = tid & 63;
    const int cid = it >> 2, h = it & 3, rowbase = cid * 64;
    const bf16* PROJ = (const bf16*)(P.ws + WS_PROJ); const float* GT = (const float*)(P.ws + WS_GATES);
#pragma unroll
    for (int j = 0; j < 2; ++j) { const int idx = tid + 512 * j, s = (idx >> 2) & 63, dg = (idx & 3) | (((idx >> 8) & 3) << 2);
        const bf16* src = PROJ + (size_t)(rowbase + s) * NPROJ + h * 128 + dg * 8;
        R.q[j] = *(const u32x4*)(src + C_QM); R.k[j] = *(const u32x4*)(src + C_KM); R.v[j] = *(const u32x4*)(src + C_VM); }
    { const bf16* CT = (const bf16*)(P.ws + WS_CT) + (size_t)it * 16384;
#pragma unroll
      for (int j = 0; j < 4; ++j) { const int idx = tid + 512 * j, v = idx >> 4, dg = idx & 15; R.ct[j] = *(const u32x4*)(CT + v * 128 + dg * 8); } }
    R.nv = ((const float*)(P.ws + WS_NST))[(size_t)it * 128 + (tid & 127)];
    R.gi = GT[(size_t)(rowbase + lane) * 8 + h]; R.glf = GT[(size_t)(rowbase + lane) * 8 + 4 + h];
    R.mn = ((const float*)(P.ws + WS_MST))[it];
    { const int t = tid >> 3, part = tid & 7; const bf16* om = PROJ + (size_t)(rowbase + t) * NPROJ + C_OM + h * 128 + part * 16;
      R.om[0] = *(const u32x4*)om; R.om[1] = *(const u32x4*)(om + 8); }
}
DI void ml_item(const Params& P, unsigned char* lds, int it, MlR& R, int next_it) {
    const int tid = threadIdx.x, lane = tid & 63, wave = tid >> 6, ql = lane & 31, half = lane >> 5;
    bf16* sQ = (bf16*)lds; bf16* sK = (bf16*)(lds + 17408); bf16* sV = (bf16*)(lds + 34816); bf16* sCt = (bf16*)(lds + 55296);
    bf16* sP = (bf16*)(lds + 90112); float* sH = (float*)(lds + 99328); float* ar = (float*)(lds + 133120);
    float* a_e = ar, *a_mx = ar + 64, *a_wi = ar + 128, *a_enm = ar + 192, *a_qn = ar + 256, *a_scl = ar + 320, *a_nv = ar + 384;
    const int cid = it >> 2, h = it & 3, rowbase = cid * 64;
    const bf16* PROJ = (const bf16*)(P.ws + WS_PROJ); bf16* MIX = (bf16*)(P.ws + WS_H1);
#pragma unroll
    for (int j = 0; j < 2; ++j) { const int idx = tid + 512 * j, s = (idx >> 2) & 63, dg = (idx & 3) | (((idx >> 8) & 3) << 2);
        *(u32x4*)(sQ + s * 136 + dg * 8) = R.q[j];
        *(u32x4*)(sK + s * 136 + dg * 8) = R.k[j];
        *(u32x4*)(sV + s * 160 + dg * 8) = R.v[j]; }
#pragma unroll
    for (int j = 0; j < 4; ++j) { const int idx = tid + 512 * j, v = idx >> 4, dg = idx & 15; *(u32x4*)(sCt + v * 136 + dg * 8) = R.ct[j]; }
    if (tid < 128) a_nv[tid] = R.nv;
    if (wave == 0) {
        const float m_n = R.mn, iv = R.gi, lf = R.glf;
        const float b = wave_scan_add(lf, lane), e = iv - b, pm = wave_scan_max(e, lane), mxv = fmaxf(m_n, pm);
        a_e[lane] = e; a_mx[lane] = mxv; a_wi[lane] = __expf(m_n - mxv); a_enm[lane] = __expf(-(b + mxv));
    }
    const u32x4 om0 = R.om[0], om1 = R.om[1];
    if (next_it >= 0) ml_load(P, next_it, R);
    __syncthreads();
    if (wave < 4) { const int tt = wave >> 1, ss = wave & 1;
        f32x16 acc;
#pragma unroll
        for (int r = 0; r < 16; ++r) acc[r] = 0.f;
        if (!(tt == 0 && ss == 1)) {
#pragma unroll
            for (int kk = 0; kk < 8; ++kk) { const bf16x8 a = *(const bf16x8*)(sQ + (tt * 32 + ql) * 136 + kk * 16 + half * 8), bb = *(const bf16x8*)(sK + (ss * 32 + ql) * 136 + kk * 16 + half * 8);
                acc = MFMA32(a, bb, acc); } }
        const int s = ss * 32 + ql; const float es = a_e[s];
#pragma unroll
        for (int r = 0; r < 16; ++r) { const int t = tt * 32 + 8 * (r >> 2) + 4 * half + (r & 3);
            const float val = (s <= t) ? acc[r] * __expf(es - a_mx[t]) : 0.f;
            sP[t * 72 + s] = (bf16)(pk2(val, 0.f) & 0xffffu); }
    } else { const int idx = tid - 256, t = idx >> 2, part = idx & 3; float s = 0.f;
#pragma unroll 8
        for (int d = 0; d < 32; ++d) s += bf2f(sQ[t * 136 + part * 32 + d]) * a_nv[part * 32 + d];
        s += __shfl_xor(s, 1); s += __shfl_xor(s, 2);
        if (part == 0) a_qn[t] = s; }
    __syncthreads();
    { const int t = tid >> 3, part = tid & 7; const u32x4 pw = *(const u32x4*)(sP + t * 72 + part * 8);
      float s = ((bflo(pw.x) + bfhi(pw.x)) + (bflo(pw.y) + bfhi(pw.y))) + ((bflo(pw.z) + bfhi(pw.z)) + (bflo(pw.w) + bfhi(pw.w)));
      s += __shfl_xor(s, 1); s += __shfl_xor(s, 2); s += __shfl_xor(s, 4);
      if (part == 0) { const float den = s + a_wi[t] * a_qn[t]; a_scl[t] = 1.f / fmaxf(fabsf(den), a_enm[t]); } }
    __syncthreads();
    { const int tt = wave & 1, vc = wave >> 1;
      f32x16 a1, a2;
#pragma unroll
      for (int r = 0; r < 16; ++r) { a1[r] = 0.f; a2[r] = 0.f; }
#pragma unroll
      for (int kk = 0; kk < 4; ++kk) { const bf16x8 a = *(const bf16x8*)(sP + (tt * 32 + ql) * 72 + kk * 16 + half * 8), bb = tr_frag(sV, 160, kk * 16, vc * 32, lane);
          a1 = MFMA32(a, bb, a1); }
#pragma unroll
      for (int kk = 0; kk < 8; ++kk) { const bf16x8 a = *(const bf16x8*)(sQ + (tt * 32 + ql) * 136 + kk * 16 + half * 8), bb = *(const bf16x8*)(sCt + (vc * 32 + ql) * 136 + kk * 16 + half * 8);
          a2 = MFMA32(a, bb, a2); }
#pragma unroll
      for (int r = 0; r < 16; ++r) { const int t = tt * 32 + 8 * (r >> 2) + 4 * half + (r & 3);
          sH[t * 132 + vc * 32 + ql] = (a1[r] + a_wi[t] * a2[r]) * a_scl[t]; } }
    __syncthreads();
    { const int t = tid >> 3, part = tid & 7; f32x4 hv[4]; float ssq = 0.f;
#pragma unroll
      for (int k = 0; k < 4; ++k) { hv[k] = *(const f32x4*)(sH + t * 132 + part * 16 + k * 4); ssq += dot4(hv[k]); }
      ssq += __shfl_xor(ssq, 1); ssq += __shfl_xor(ssq, 2); ssq += __shfl_xor(ssq, 4);
      const float rstd = rsqrtf(ssq * (1.f / 128.f) + EPS);
      const float* gh = P.in[13] + h * 128 + part * 16;
      bf16* dst = MIX + (size_t)(rowbase + t) * DM + h * 128 + part * 16;
#pragma unroll
      for (int k2 = 0; k2 < 2; ++k2) { const u32x4 ow = k2 ? om1 : om0; const f32x4 g0 = *(const f32x4*)(gh + k2 * 8), g1 = *(const f32x4*)(gh + k2 * 8 + 4);
          const f32x4 h0 = hv[2 * k2], h1 = hv[2 * k2 + 1]; float r[8];
          r[0] = sigmoidf_(bflo(ow.x)) * h0.x * rstd * g0.x; r[1] = sigmoidf_(bfhi(ow.x)) * h0.y * rstd * g0.y; r[2] = sigmoidf_(bflo(ow.y)) * h0.z * rstd * g0.z; r[3] = sigmoidf_(bfhi(ow.y)) * h0.w * rstd * g0.w;
          r[4] = sigmoidf_(bflo(ow.z)) * h1.x * rstd * g1.x; r[5] = sigmoidf_(bfhi(ow.z)) * h1.y * rstd * g1.y; r[6] = sigmoidf_(bflo(ow.w)) * h1.z * rstd * g1.z; r[7] = sigmoidf_(bfhi(ow.w)) * h1.w * rstd * g1.w;
          u32x4 w; w.x = pk2(r[0], r[1]); w.y = pk2(r[2], r[3]); w.z = pk2(r[4], r[5]); w.w = pk2(r[6], r[7]);
          *(u32x4*)(dst + k2 * 8) = w; } }
    __syncthreads();
}

DI void mls_item(const Params& P, unsigned char* lds, int it) {
    const int tid = threadIdx.x, lane = tid & 63, wave = tid >> 6;
    float* sq = (float*)lds; float* sk = sq + 32 * 132; float* sv = sk + 32 * 132; float* sc0 = (float*)(lds + 50688);
    float* sS = (float*)(lds + 116224); float* ar = (float*)(lds + 120448); float* sHs = (float*)(lds + 122880);
    float* a_e = ar, *a_mx = ar + 32, *a_wi = ar + 64, *a_enm = ar + 96, *a_ws = ar + 128, *a_scl = ar + 160, *a_n0 = ar + 192, *a_sc = ar + 320;
    const int pp8 = it & 7, bh = it >> 3, b = bh >> 2, h = bh & 3, rowbase = MP + b * 32, t0 = pp8 * 4;
    const bf16* PROJ = (const bf16*)(P.ws + WS_PROJ); const float* GT = (const float*)(P.ws + WS_GATES); bf16* MIX = (bf16*)(P.ws + WS_H1);
    const float* c0g = P.in[4] + (size_t)(b * 4 + h) * 16384; const float* n0g = P.in[5] + (size_t)(b * 4 + h) * 128; const float m0 = P.in[6][b * 4 + h];
    { const int t = tid >> 4, dg = tid & 15; const bf16* src = PROJ + (size_t)(rowbase + t) * NPROJ + h * 128 + dg * 8;
      const u32x4 qw = *(const u32x4*)(src + C_QM), kw = *(const u32x4*)(src + C_KM), vw = *(const u32x4*)(src + C_VM);
#pragma unroll
      for (int e = 0; e < 4; ++e) { sq[t * 132 + dg * 8 + 2 * e] = bflo(qw[e]); sq[t * 132 + dg * 8 + 2 * e + 1] = bfhi(qw[e]);
          sk[t * 132 + dg * 8 + 2 * e] = bflo(kw[e]); sk[t * 132 + dg * 8 + 2 * e + 1] = bfhi(kw[e]);
          sv[t * 132 + dg * 8 + 2 * e] = bflo(vw[e]); sv[t * 132 + dg * 8 + 2 * e + 1] = bfhi(vw[e]); } }
    { f32x4 cv[8];
#pragma unroll
      for (int j = 0; j < 8; ++j) cv[j] = *(const f32x4*)(c0g + (tid + 512 * j) * 4);
#pragma unroll
      for (int j = 0; j < 8; ++j) *(f32x4*)(sc0 + (tid + 512 * j) * 4) = cv[j]; }
    if (tid < 128) a_n0[tid] = n0g[tid];
    if (wave == 0) {
        const bool ok = lane < 32; const int r = rowbase + (lane & 31);
        const float iv = ok ? GT[(size_t)r * 8 + h] : -1e30f, lf = ok ? GT[(size_t)r * 8 + 4 + h] : 0.f;
        const float bb = wave_scan_add(lf, lane), B = __shfl(bb, 31), e = iv - bb, pm = wave_scan_max(e, lane), mxv = fmaxf(m0, pm);
        const float mt = bb + mxv, mnew = __shfl(mt, 31);
        if (ok) { a_e[lane] = e; a_mx[lane] = mxv; a_wi[lane] = __expf(m0 - mxv); a_enm[lane] = __expf(-mt); a_ws[lane] = __expf(B + e - mnew); }
        if (lane == 0) { a_sc[0] = __expf(B + m0 - mnew); if (pp8 == 0) P.out[O_SM + b * 4 + h] = mnew; }
    }
    __syncthreads();
    if (tid < 128) { const int t = t0 + (tid >> 5), s = tid & 31; float val = 0.f;
        if (s <= t) { float d = 0.f;
#pragma unroll 4
            for (int k = 0; k < 32; ++k) { const f32x4 a = *(const f32x4*)(sq + t * 132 + k * 4), c = *(const f32x4*)(sk + s * 132 + k * 4); d += (a.x * c.x + a.y * c.y) + (a.z * c.z + a.w * c.w); }
            val = d * __expf(a_e[s] - a_mx[t]); }
        sS[t * 33 + s] = val; }
    __syncthreads();
    if (tid < 4) { const int t = t0 + tid; float s = 0.f, qn = 0.f;
#pragma unroll 4
        for (int k = 0; k < 32; ++k) s += sS[t * 33 + k];
#pragma unroll 4
        for (int d = 0; d < 128; ++d) qn += sq[t * 132 + d] * a_n0[d];
        const float den = s + a_wi[t] * qn; a_scl[t] = 1.f / fmaxf(fabsf(den), a_enm[t]); }
    __syncthreads();
    { const int v = tid & 127, tg = tid >> 7, t = t0 + tg; float a1 = 0.f, a2 = 0.f;
#pragma unroll 4
      for (int s = 0; s < 32; ++s) a1 += sS[t * 33 + s] * sv[s * 132 + v];
#pragma unroll 4
      for (int d = 0; d < 128; ++d) a2 += sq[t * 132 + d] * sc0[d * 128 + v];
      sHs[t * 132 + v] = (a1 + a_wi[t] * a2) * a_scl[t];
      const float w_c = a_sc[0]; float* oc = P.out + O_SC + (size_t)(b * 4 + h) * 16384;
#pragma unroll 1
      for (int dd = 0; dd < 4; ++dd) { const int d = pp8 * 16 + tg * 4 + dd; float acc = w_c * sc0[d * 128 + v];
#pragma unroll 4
          for (int s = 0; s < 32; ++s) acc += (a_ws[s] * sk[s * 132 + d]) * sv[s * 132 + v];
          oc[d * 128 + v] = acc; }
      if (tid < 16) { const int d = pp8 * 16 + tid; float acc = w_c * a_n0[d];
#pragma unroll 4
          for (int s = 0; s < 32; ++s) acc += a_ws[s] * sk[s * 132 + d];
          P.out[O_SN + (b * 4 + h) * 128 + d] = acc; } }
    __syncthreads();
    if (tid < 64) { const int t = t0 + (tid >> 4), part = tid & 15; const f32x4 h0 = *(const f32x4*)(sHs + t * 132 + part * 8), h1 = *(const f32x4*)(sHs + t * 132 + part * 8 + 4);
      float ssq = dot4(h0) + dot4(h1);
      ssq += __shfl_xor(ssq, 1); ssq += __shfl_xor(ssq, 2); ssq += __shfl_xor(ssq, 4); ssq += __shfl_xor(ssq, 8);
      const float rstd = rsqrtf(ssq * (1.f / 128.f) + EPS);
      const bf16* om = PROJ + (size_t)(rowbase + t) * NPROJ + C_OM + h * 128 + part * 8; const float* gh = P.in[13] + h * 128 + part * 8;
      const u32x4 ow = *(const u32x4*)om; const f32x4 g0 = *(const f32x4*)gh, g1 = *(const f32x4*)(gh + 4); float r[8];
      r[0] = sigmoidf_(bflo(ow.x)) * h0.x * rstd * g0.x; r[1] = sigmoidf_(bfhi(ow.x)) * h0.y * rstd * g0.y; r[2] = sigmoidf_(bflo(ow.y)) * h0.z * rstd * g0.z; r[3] = sigmoidf_(bfhi(ow.y)) * h0.w * rstd * g0.w;
      r[4] = sigmoidf_(bflo(ow.z)) * h1.x * rstd * g1.x; r[5] = sigmoidf_(bfhi(ow.z)) * h1.y * rstd * g1.y; r[6] = sigmoidf_(bflo(ow.w)) * h1.z * rstd * g1.z; r[7] = sigmoidf_(bfhi(ow.w)) * h1.w * rstd * g1.w;
      u32x4 w; w.x = pk2(r[0], r[1]); w.y = pk2(r[2], r[3]); w.z = pk2(r[4], r[5]); w.w = pk2(r[6], r[7]);
      *(u32x4*)(MIX + (size_t)(rowbase + t) * DM + h * 128 + part * 8) = w; }
    __syncthreads();
}

DI void final_norm(const Params& P, int bid, int G, int nrows) {
    const int lane = threadIdx.x & 63, wave = threadIdx.x >> 6; const float* __restrict__ gf = P.in[22]; const float* __restrict__ ssq = (const float*)(P.ws + WS_SSQA);
    const bf16* __restrict__ X3 = (const bf16*)(P.ws + WS_X1B); float* __restrict__ out = P.out;
    const f32x4 g0 = *(const f32x4*)(gf + lane * 8), g1 = *(const f32x4*)(gf + lane * 8 + 4), g2 = *(const f32x4*)(gf + lane * 8 + 512), g3 = *(const f32x4*)(gf + lane * 8 + 516);
    const int NW = G * 8;
    for (int r0 = bid * 8 + wave; r0 < nrows; r0 += 2 * NW) {
        const int r1 = r0 + NW; const bool two = r1 < nrows; const int r1c = two ? r1 : r0;
        const u32x4 a0 = *(const u32x4*)(X3 + (size_t)r0 * DM + lane * 8), a1 = *(const u32x4*)(X3 + (size_t)r0 * DM + lane * 8 + 512);
        const u32x4 b0 = *(const u32x4*)(X3 + (size_t)r1c * DM + lane * 8), b1 = *(const u32x4*)(X3 + (size_t)r1c * DM + lane * 8 + 512);
        const float rs0 = row_rstd(ssq, r0), rs1 = row_rstd(ssq, r1c);
        float* y0 = out + (size_t)r0 * DM + lane * 8; float* y1 = out + (size_t)r1c * DM + lane * 8;
        *(f32x4*)(y0) = (f32x4){bflo(a0.x), bfhi(a0.x), bflo(a0.y), bfhi(a0.y)} * rs0 * g0; *(f32x4*)(y0 + 4) = (f32x4){bflo(a0.z), bfhi(a0.z), bflo(a0.w), bfhi(a0.w)} * rs0 * g1;
        *(f32x4*)(y0 + 512) = (f32x4){bflo(a1.x), bfhi(a1.x), bflo(a1.y), bfhi(a1.y)} * rs0 * g2; *(f32x4*)(y0 + 516) = (f32x4){bflo(a1.z), bfhi(a1.z), bflo(a1.w), bfhi(a1.w)} * rs0 * g3;
        if (two) {
        *(f32x4*)(y1) = (f32x4){bflo(b0.x), bfhi(b0.x), bflo(b0.y), bfhi(b0.y)} * rs1 * g0; *(f32x4*)(y1 + 4) = (f32x4){bflo(b0.z), bfhi(b0.z), bflo(b0.w), bfhi(b0.w)} * rs1 * g1;
        *(f32x4*)(y1 + 512) = (f32x4){bflo(b1.x), bfhi(b1.x), bflo(b1.y), bfhi(b1.y)} * rs1 * g2; *(f32x4*)(y1 + 516) = (f32x4){bflo(b1.z), bfhi(b1.z), bflo(b1.w), bfhi(b1.w)} * rs1 * g3; }
    }
}

#define LAS __attribute__((address_space(3)))
#define XB_TMO      128
#define XB_XCNT(j)  (256  + 64 * (j))
#define XB_XSUB(j)  (1280 + 64 * (j))
#define XB_XGEN(j)  (2304 + 64 * (j))
#define XB_TOP      3328
#define XB_TOPGEN   3392
#define XCD_BAR_WORDS 3456
#define XB_SPIN_CAP (1u << 18)

__device__ __forceinline__ unsigned xb_ld(unsigned* p)              { return __hip_atomic_load(p, __ATOMIC_RELAXED, __HIP_MEMORY_SCOPE_AGENT); }
__device__ __forceinline__ unsigned xb_add(unsigned* p, unsigned v) { return __hip_atomic_fetch_add(p, v, __ATOMIC_RELAXED, __HIP_MEMORY_SCOPE_AGENT); }
__device__ __forceinline__ unsigned xb_xcc_id() { return (unsigned)__builtin_amdgcn_s_getreg((3 << 11) | 20) & 0xFu; }
#define XB_SPIN(cond, bar) do { unsigned _sp = 0; while (cond) { __builtin_amdgcn_s_sleep(1); \
    if ((++_sp & 255u) == 0u) { if (xb_ld(&(bar)[XB_TMO])) break; if (_sp > XB_SPIN_CAP) { atomicAdd(&(bar)[XB_TMO], 1u); break; } } } } while (0)

struct XcdBarrier {
    unsigned* bar; unsigned x;
    volatile LAS unsigned* st;
};

__device__ __forceinline__ XcdBarrier xcd_barrier_post(unsigned* bar, volatile LAS unsigned* st) {
    XcdBarrier b; b.bar = bar; b.x = xb_xcc_id(); b.st = st;
    if (threadIdx.x == 0) (void)xb_add(&bar[XB_XCNT(b.x)], 1u);
    return b;
}
__device__ __forceinline__ void xcd_barrier_complete(unsigned* bar, unsigned x, unsigned& nloc, unsigned& nx) {
    const unsigned G = gridDim.x * gridDim.y * gridDim.z;
    unsigned sum, cnt, mine, sp = 0u;
    for (;;) {
        sum = 0u; cnt = 0u; mine = 0u;
#pragma unroll
        for (unsigned j = 0; j < 16; ++j) { const unsigned c = xb_ld(&bar[XB_XCNT(j)]); sum += c; cnt += (c > 0u) ? 1u : 0u; mine = (j == x) ? c : mine; }
        if (sum == G) break;
        __builtin_amdgcn_s_sleep(1);
        if ((++sp & 255u) == 0u) { if (xb_ld(&bar[XB_TMO])) break; if (sp > XB_SPIN_CAP) { atomicAdd(&bar[XB_TMO], 1u); break; } }
    }
    nloc = mine > 0u ? mine : 1u; nx = cnt > 0u ? cnt : 1u;
}

__device__ __forceinline__ void xcd_barrier(const XcdBarrier& b) {
    asm volatile("s_waitcnt vmcnt(0)" ::: "memory");
    __syncthreads();
    if (threadIdx.x == 0) {
        unsigned* bar = b.bar;
        __builtin_amdgcn_s_waitcnt(0);
        unsigned nloc = b.st[0], nx = b.st[1];
        if (nloc == 0u) { xcd_barrier_complete(bar, b.x, nloc, nx); b.st[0] = nloc; b.st[1] = nx; }
        const unsigned old = xb_add(&bar[XB_XSUB(b.x)], 1u);
        const unsigned gen = old / nloc;
        if (old + 1u == (gen + 1u) * nloc) {
            __builtin_amdgcn_fence(__ATOMIC_RELEASE, "agent");
            asm volatile("s_waitcnt vmcnt(0)" ::: "memory");
            const unsigned og = xb_add(&bar[XB_TOP], 1u);
            const unsigned tg = og / nx;
            if (og + 1u == (tg + 1u) * nx) xb_add(&bar[XB_TOPGEN], 1u);
            else XB_SPIN(xb_ld(&bar[XB_TOPGEN]) == tg, bar);
            __builtin_amdgcn_fence(__ATOMIC_ACQUIRE, "agent");
            xb_add(&bar[XB_XGEN(b.x)], 1u);
            asm volatile("s_waitcnt vmcnt(0)" ::: "memory");
        } else {
            XB_SPIN(xb_ld(&bar[XB_XGEN(b.x)]) == gen, bar);
            __builtin_amdgcn_fence(__ATOMIC_ACQUIRE, "agent");
            asm volatile("s_waitcnt vmcnt(0)" ::: "memory");
        }
    }
    __syncthreads();
}


__global__ void __launch_bounds__(512, 2) hymba_fwd(Params P) {
    extern __shared__ __attribute__((aligned(16))) unsigned char lds_raw[];
    cg::grid_group grid = cg::this_grid();
    PG8_LAS unsigned char* ldsg = (PG8_LAS unsigned char*)lds_raw;
    unsigned char* lds = lds_raw;
    const int bid = blockIdx.x, G = gridDim.x, lo = P.ph_lo, hi = P.ph_hi;
    unsigned char* ws = P.ws;
    volatile LAS unsigned* bst = (volatile LAS unsigned*)(ldsg + (LDS_BYTES - 64));
    if (threadIdx.x < 2) bst[threadIdx.x] = 0u;
    __syncthreads();
    XcdBarrier xbar; xbar.bar = (unsigned*)(ws + WS_BAR); xbar.x = 0; xbar.st = nullptr;
    if (hi - lo > 1) xbar = xcd_barrier_post((unsigned*)(ws + WS_BAR), bst);
#ifndef TST
#define TST 31
#endif
#ifndef PH_MASK
#define PH_MASK 0x3ff
#endif
#define IN(k) (((PH_MASK >> (k)) & 1) && lo <= (k) && (k) < hi)
#define SEAM(k) do { if (IN(k) && IN((k) + 1)) { if (lo < 0) grid.sync(); xcd_barrier(xbar); } } while (0)
    if (IN(0)) { phase0(P, lds, bid, G); } SEAM(0);
    if (IN(1)) { pg8::Gemm g{(const bf16*)(ws + WS_H1), (const bf16*)(ws + WS_WIN), MP, NPROJ, DM}; pg8::StaticOrder S; S.init(MP, NPROJ, G, bid);
        EpiStore E{(bf16*)(ws + WS_PROJ), NPROJ}; pg8::gemm_phase<EpiStore, pg8::StaticOrder, true, true>(ldsg, g, S, E);
        SEpiStore SE{(bf16*)(ws + WS_PROJ), NPROJ}; if (G == 256) { if (bid >= 192) small_gemm<DM>(g.A, g.Bt, NPROJ, lds, bid - 192, 64, SE); }
        else small_gemm<DM>(g.A, g.Bt, NPROJ, lds, G - 1 - bid, G, SE); } SEAM(1);
    if (IN(2)) { constexpr int N_AT = 512, N_DC = 1024, N_AS = 16, N_KV = 160;
        if (bid & 1) for (int it = bid; it < N_DC; it += G) dc_item(P, lds, it);
        for (int it = bid; it < N_AT; it += G) attn_item<false>(P, lds, it);
        if (!(bid & 1)) for (int it = bid; it < N_DC; it += G) dc_item(P, lds, it);
        for (int it = G - 1 - bid; it < N_AS; it += G) attn_item<true>(P, lds, it);
        for (int it = bid; it < N_KV; it += G) kvcopy_item(P, it); } SEAM(2);
    if (IN(3)) { for (int it = bid; it < 256; it += G) scan_item(P, lds, it); } SEAM(3);
    if (IN(4)) { if (bid & 1) for (int it = bid; it < 256; it += G) mls_item(P, lds, it);
        { MlR R; if (bid < 1024) ml_load(P, bid, R); for (int it = bid; it < 1024; it += G) ml_item(P, lds, it, R, it + G < 1024 ? it + G : -1); } if (!(bid & 1)) for (int it = bid; it < 256; it += G) mls_item(P, lds, it); } SEAM(4);
    if (IN(5)) { pg8::Gemm g{(const bf16*)(ws + WS_H1), (const bf16*)(ws + WS_WOUT), MP, DM, DM}; pg8::StaticOrder S; S.init(MP, DM, G, bid);
        SEpiResid<false> SE{P.in[1], nullptr, (bf16*)(ws + WS_X1B), (float*)(ws + WS_SSQA)};
        if (bid & 1) small_gemm<DM>(g.A, g.Bt, DM, lds, bid >> 1, G >> 1, SE);
        EpiResid<false> E{P.in[0], nullptr, (bf16*)(ws + WS_X1B), (float*)(ws + WS_SSQA)}; pg8::gemm_phase<EpiResid<false>, pg8::StaticOrder, true, true>(ldsg, g, S, E); } SEAM(5);
    if (IN(6)) { pg8::Gemm g{(const bf16*)(ws + WS_X1B), (const bf16*)(ws + WS_WUP), MP, DFF, DM}; pg8::StaticOrder S; S.init(MP, DFF, G, bid);
        EpiUp E{(bf16*)(ws + WS_U), (const float*)(ws + WS_SSQA)}; SEpiUp SE{(bf16*)(ws + WS_U), (const float*)(ws + WS_SSQA)};
        if (bid & 1) small_gemm<DM>(g.A, g.Bt, DFF, lds, bid, G, SE);
        pg8::gemm_phase<EpiUp, pg8::StaticOrder, true, true>(ldsg, g, S, E);
        if (!(bid & 1)) small_gemm<DM>(g.A, g.Bt, DFF, lds, bid, G, SE); } SEAM(6);
    if (IN(7)) { pg8::Gemm g{(const bf16*)(ws + WS_U), (const bf16*)(ws + WS_WDOWN), MP, DM, DFF}; pg8::StaticOrder S; S.init(MP, DM, G, bid);
        SEpiResid<true> SE{nullptr, (const bf16*)(ws + WS_X1B), (bf16*)(ws + WS_H1), (float*)(ws + WS_SSQB)};
        if (bid & 1) small_gemm<DFF>(g.A, g.Bt, DM, lds, bid >> 1, G >> 1, SE);
        EpiResid<true> E{nullptr, (const bf16*)(ws + WS_X1B), (bf16*)(ws + WS_H1), (float*)(ws + WS_SSQB)}; pg8::gemm_phase<EpiResid<true>, pg8::StaticOrder, true, true>(ldsg, g, S, E); } SEAM(7);
    if (IN(8)) { pg8::Gemm gp{(const bf16*)(ws + WS_PB), (const bf16*)(ws + WS_WPP), MP, DM, PLE}; pg8::Gemm g{(const bf16*)(ws + WS_H1), (const bf16*)(ws + WS_WGATE), MP, DM, DM};
        unsigned* cnt = (unsigned*)(ws + WS_CNT);
        if (bid & 1) {
          SEpiStore SEp{(bf16*)(ws + WS_PP), DM}; small_gemm<PLE>(gp.A, gp.Bt, DM, lds, bid >> 1, G >> 1, SEp);
          SEpiPle SE{(const bf16*)(ws + WS_H1), (const bf16*)(ws + WS_PP), (bf16*)(ws + WS_X1B), (const float*)(ws + WS_SSQB), (float*)(ws + WS_SSQA)};
          small_gemm<DM, SEpiPle, FUSE_FINAL != 0>(g.A, g.Bt, DM, lds, bid >> 1, G >> 1, SE, cnt, P.in[22], P.out); }
        { pg8::StaticOrder S; S.init(MP, DM, G, bid); EpiStore E{(bf16*)(ws + WS_PP), DM}; pg8::gemm_phase<EpiStore, pg8::StaticOrder, true, true>(ldsg, gp, S, E); }
        { pg8::StaticOrder S; S.init(MP, DM, G, bid);
          if (FUSE_FINAL && G == 256) { EpiPleNorm E{(const bf16*)(ws + WS_H1), (const bf16*)(ws + WS_PP), P.out, (const float*)(ws + WS_SSQB), (float*)(ws + WS_SSQA), cnt, P.in[22]};
              pg8::gemm_phase<EpiPleNorm, pg8::StaticOrder, true, true>(ldsg, g, S, E); }
          else { EpiPle E{(const bf16*)(ws + WS_H1), (const bf16*)(ws + WS_PP), (bf16*)(ws + WS_X1B), (const float*)(ws + WS_SSQB), (float*)(ws + WS_SSQA)};
              pg8::gemm_phase<EpiPle, pg8::StaticOrder, true, true>(ldsg, g, S, E); } } } SEAM(8);
    if (IN(9)) { if (!FUSE_FINAL) final_norm(P, bid, G, MT); else if (G != 256) final_norm(P, bid, G, MP); }
#undef IN
#undef SEAM
}

constexpr int N_PHASES = 10;
#ifndef REP_MASK
#define REP_MASK 0
#endif
#ifndef MK_ONE_LAUNCH
#define MK_ONE_LAUNCH 1
#endif
extern "C" void kernel_launch(void* const* d_in, const int* in_sizes, int n_in, void* d_out, int out_size, void* d_ws, size_t ws_size, hipStream_t stream) {
    static int grid_blocks = 0;
    if (!grid_blocks) {
        int dev = 0, cus = 0, per_cu = 0;
        hipGetDevice(&dev);
        hipDeviceGetAttribute(&cus, hipDeviceAttributeMultiprocessorCount, dev);
        hipFuncSetAttribute((const void*)hymba_fwd, hipFuncAttributeMaxDynamicSharedMemorySize, LDS_BYTES);
        hipOccupancyMaxActiveBlocksPerMultiprocessor(&per_cu, (const void*)hymba_fwd, 512, LDS_BYTES);
        if (per_cu < 1) { fprintf(stderr, "kernel_launch: occupancy query says %d blocks per CU\n", per_cu); per_cu = 1; }
        grid_blocks = cus * per_cu;
        if (n_in != 23 || ws_size < 256 * MiB) fprintf(stderr, "kernel_launch: unexpected n_in %d / ws_size %zu\n", n_in, ws_size);
    }
    Params p{};
    for (int i = 0; i < 23; ++i) p.in[i] = (const float*)d_in[i];
    p.out = (float*)d_out; p.ws = (unsigned char*)d_ws;
#if MK_ONE_LAUNCH
    (void)hipMemsetAsync((unsigned char*)d_ws + WS_BAR, 0, 16384, stream);
#if FUSE_FINAL
    (void)hipMemsetAsync((unsigned char*)d_ws + WS_CNT, 0, 32768, stream);
#endif
    p.ph_lo = 0; p.ph_hi = N_PHASES;
    void* args[] = {&p};
    hipError_t e = hipLaunchCooperativeKernel((const void*)hymba_fwd, dim3(grid_blocks), dim3(512), args, LDS_BYTES, stream);
    if (e != hipSuccess) fprintf(stderr, "cooperative launch failed: %s (grid %d)\n", hipGetErrorString(e), grid_blocks);
#else
    for (int k = 0; k < N_PHASES; ++k) { p.ph_lo = k; p.ph_hi = k + 1;
        for (int rep = 0; rep < (((REP_MASK >> k) & 1) ? 2 : 1); ++rep) hipLaunchKernelGGL(hymba_fwd, dim3(grid_blocks), dim3(512), LDS_BYTES, stream, p); }
#endif
}
```

```cpp
#include <hip/hip_runtime.h>
#include <hip/hip_cooperative_groups.h>
#include <cstdio>
#include <cstdint>
namespace cg = cooperative_groups;
namespace pg8 {
#define PG8_LAS __attribute__((address_space(3)))
typedef unsigned short bf16_t;
typedef short bf16x8 __attribute__((ext_vector_type(8)));
typedef float f32x4 __attribute__((ext_vector_type(4)));
typedef unsigned u32x4 __attribute__((ext_vector_type(4)));
constexpr int BM = 256, BK = 64, HALF = 128, HTB = HALF * BK * 2  , STAGE_BYTES = 8 * HTB, NXCD = 8, WGM = 8;

__host__ __device__ __forceinline__ int lds_byte(int r, int c) { const int st = (r >> 4) * 2 + (c >> 5), rr = r & 15, cc = c & 31, ob = rr * 64 + cc * 2; return st * 1024 + (ob ^ (((ob >> 9) & 1) << 5)); }
__host__ __device__ __forceinline__ void stage_rc(int b, int& R, int& C) { const int st = b / 1024, sb = b % 1024, swz = sb ^ (((sb >> 9) & 1) << 5); R = (st >> 1) * 16 + swz / 64; C = (st & 1) * 32 + (swz % 64) / 2; }
__host__ __device__ __forceinline__ int perm32(int rho) { const int n = rho >> 4, i = rho & 15; return 8 * (i >> 2) + 4 * n + (i & 3); }

struct Unit { int pm, pn; };
struct Gemm { const bf16_t* A; const bf16_t* Bt; int M, N, K; };

struct StaticOrder {
    int nM, nN, nwg, G, c;
    __host__ __device__ void init(int M, int N, int G_, int c_) { nM = M / BM; nN = N / BM; nwg = nM * nN; G = G_; c = c_; }
    __host__ __device__ bool next(int i, Unit& u) const {
        const long L = (long)i * G + c; if (L >= nwg) return false;
        int wgid = (int)L; { const int q = nwg / NXCD, r = nwg % NXCD, xcd = wgid % NXCD, off = wgid / NXCD; wgid = (xcd < r ? xcd * (q + 1) : r * (q + 1) + (xcd - r) * q) + off; }
        const int nig = WGM * nN, gid = wgid / nig, fm = gid * WGM, gsz = (nM - fm) < WGM ? (nM - fm) : WGM;
        u.pm = fm + ((wgid % nig) % gsz); u.pn = (wgid % nig) / gsz; return true;
    }
    __device__ __forceinline__ void a_ready(const Unit&) const {}
    __device__ __forceinline__ void done(const Unit&) const {}
};

__device__ __forceinline__ unsigned cvt_pk_bf16(float lo, float hi) { unsigned r; asm volatile("v_cvt_pk_bf16_f32 %0, %1, %2" : "=v"(r) : "v"(lo), "v"(hi)); return r; }
template <class Epi, class Sched, bool ALIGN_EPI = false, bool SP2 = false>
__device__ __forceinline__ void gemm_phase(PG8_LAS unsigned char* lds, const Gemm g, const Sched& S, const Epi& E) {
    const int tid = threadIdx.x, wid = __builtin_amdgcn_readfirstlane(tid >> 6), lane = tid & 63, wr = wid >> 2, wc = wid & 3, fr = lane & 15, fq = lane >> 4;
    const int K = g.K, nt = K / BK;
    unsigned voffA[2], voffB[2];
#pragma unroll
    for (int i = 0; i < 2; ++i) { int R, C; stage_rc(tid * 16 + i * 8192, R, C); const int Rb = Epi::PERM ? ((R & ~31) + perm32(R & 31)) : R;
        voffA[i] = (unsigned)(R * K + C) * 2u; voffB[i] = (unsigned)(Rb * K + C) * 2u; }
    const size_t kstep = (size_t)(BK * 2);
    const size_t hstep = (size_t)HALF * K * 2;
    const size_t tstep = 2 * hstep;
    const unsigned ldsw = (unsigned)wid * 1024u;
    const int aoff = lds_byte(wr * 64 + fr, fq * 8), boff = lds_byte(wc * 32 + fr, fq * 8);
#define PG8_SA(b, h) (((b) * 2 + (h)) * HTB)
#define PG8_SB(b, h) ((4 + (b) * 2 + (h)) * HTB)
#define PG8_STAGE(bufoff, gbase, voff) do { _Pragma("unroll") for (int _i = 0; _i < 2; ++_i) \
        __builtin_amdgcn_global_load_lds((const unsigned*)((const char*)(gbase) + (voff)[_i]), (PG8_LAS unsigned*)(lds + (bufoff) + ldsw + _i * 8192), 16, 0, 0); } while (0)
#define PG8_LDA(dst, b, h) do { _Pragma("unroll") for (int m = 0; m < 4; ++m) _Pragma("unroll") for (int k = 0; k < 2; ++k) dst[m][k] = *(const PG8_LAS bf16x8*)(lds + PG8_SA(b, h) + aoff + m * 2048 + k * 1024); } while (0)
#define PG8_LDB(dst, b, h) do { _Pragma("unroll") for (int n = 0; n < 2; ++n) _Pragma("unroll") for (int k = 0; k < 2; ++k) dst[n][k] = *(const PG8_LAS bf16x8*)(lds + PG8_SB(b, h) + boff + n * 2048 + k * 1024); } while (0)
#define PG8_MMA(ai, bj, At, Bt) do { __builtin_amdgcn_s_setprio(1); _Pragma("unroll") for (int m = 0; m < 4; ++m) _Pragma("unroll") for (int n = 0; n < 2; ++n) _Pragma("unroll") for (int k = 0; k < 2; ++k) \
        acc[ai][bj][m][n] = __builtin_amdgcn_mfma_f32_16x16x32_bf16(Bt[n][k], At[m][k], acc[ai][bj][m][n], 0, 0, 0); __builtin_amdgcn_s_setprio(0); } while (0)
#define PG8_WAIT_V(n) asm volatile("s_waitcnt vmcnt(" #n ")" ::: "memory")
#define PG8_WAIT_L(n) asm volatile("s_waitcnt lgkmcnt(" #n ")" ::: "memory")
#define PG8_BAR __builtin_amdgcn_s_barrier()
#define PG8_SCHED __builtin_amdgcn_sched_barrier(0)
    Unit cur, nxt; int ui = 0;
    if (!S.next(0, cur)) return;
    f32x4 acc[2][2][4][2];
#pragma unroll
    for (int a = 0; a < 2; ++a)
#pragma unroll
        for (int b = 0; b < 2; ++b)
#pragma unroll
            for (int m = 0; m < 4; ++m)
#pragma unroll
                for (int n = 0; n < 2; ++n) acc[a][b][m][n] = (f32x4){0.f, 0.f, 0.f, 0.f};
    bf16x8 At[4][2], B0[2][2], B1[2][2];
    const char* cA = (const char*)g.A + (size_t)cur.pm * tstep; const char* cB = (const char*)g.Bt + (size_t)cur.pn * tstep;
    S.a_ready(cur);
    if constexpr (SP2) {
        PG8_STAGE(PG8_SB(0, 0), cB, voffB); PG8_STAGE(PG8_SB(0, 1), cB + hstep, voffB); PG8_STAGE(PG8_SA(0, 0), cA, voffA); PG8_STAGE(PG8_SA(0, 1), cA + hstep, voffA);
        if (wr == 1) PG8_BAR;
        PG8_WAIT_V(2); PG8_BAR;
        PG8_STAGE(PG8_SB(1, 0), cB + kstep, voffB); PG8_STAGE(PG8_SA(1, 0), cA + kstep, voffA); PG8_STAGE(PG8_SB(1, 1), cB + hstep + kstep, voffB);
        PG8_WAIT_V(6); PG8_BAR;
    } else {
        PG8_STAGE(PG8_SB(0, 0), cB, voffB); PG8_STAGE(PG8_SA(0, 0), cA, voffA); PG8_STAGE(PG8_SB(0, 1), cB + hstep, voffB); PG8_STAGE(PG8_SA(0, 1), cA + hstep, voffA);
        if (wr == 1) PG8_BAR;
        PG8_WAIT_V(4); PG8_BAR;
        PG8_STAGE(PG8_SB(1, 0), cB + kstep, voffB); PG8_STAGE(PG8_SA(1, 0), cA + kstep, voffA); PG8_STAGE(PG8_SB(1, 1), cB + hstep + kstep, voffB);
        PG8_WAIT_V(6); PG8_BAR;
    }
    for (;;) {
        const bool has_next = S.next(ui + 1, nxt);
        const char* nA = has_next ? (const char*)g.A + (size_t)nxt.pm * tstep : cA; const char* nB = has_next ? (const char*)g.Bt + (size_t)nxt.pn * tstep : cB;
        for (int t = 0; t < nt; t += 2) {
            const bool last = (t == nt - 2);
            const char* a1 = cA + (size_t)(t + 1) * kstep;
            const char* a2 = last ? nA : cA + (size_t)(t + 2) * kstep; const char* b2 = last ? nB : cB + (size_t)(t + 2) * kstep;
            const char* a3 = a2 + kstep; const char* b3 = b2 + kstep;
            if (last && has_next) S.a_ready(nxt);
            if constexpr (SP2) {
            PG8_LDB(B0, 0, 0); PG8_LDB(B1, 0, 1); PG8_SCHED; PG8_LDA(At, 0, 0); PG8_STAGE(PG8_SA(1, 1), a1 + hstep, voffA);
            PG8_WAIT_V(8); PG8_WAIT_L(0); PG8_BAR; PG8_MMA(0, 0, At, B0); PG8_MMA(0, 1, At, B1); PG8_BAR; PG8_SCHED;
            PG8_LDA(At, 0, 1); PG8_STAGE(PG8_SB(0, 0), b2, voffB); PG8_STAGE(PG8_SB(0, 1), b2 + hstep, voffB); PG8_STAGE(PG8_SA(0, 0), a2, voffA);
            PG8_WAIT_V(8); PG8_WAIT_L(0); PG8_BAR; PG8_MMA(1, 0, At, B0); PG8_MMA(1, 1, At, B1); PG8_BAR; PG8_SCHED;
            PG8_LDB(B0, 1, 0); PG8_LDB(B1, 1, 1); PG8_SCHED; PG8_LDA(At, 1, 0); PG8_STAGE(PG8_SA(0, 1), a2 + hstep, voffA);
            PG8_WAIT_V(8); PG8_WAIT_L(0); PG8_BAR; PG8_MMA(0, 0, At, B0); PG8_MMA(0, 1, At, B1); PG8_BAR; PG8_SCHED;
            PG8_LDA(At, 1, 1); PG8_STAGE(PG8_SB(1, 0), b3, voffB); PG8_STAGE(PG8_SB(1, 1), b3 + hstep, voffB); PG8_STAGE(PG8_SA(1, 0), a3, voffA);
            PG8_WAIT_V(8); PG8_WAIT_L(0); PG8_BAR; PG8_MMA(1, 0, At, B0); PG8_MMA(1, 1, At, B1); PG8_BAR; PG8_SCHED;
            } else {
            PG8_LDB(B0, 0, 0); PG8_SCHED; PG8_LDA(At, 0, 0); PG8_STAGE(PG8_SA(1, 1), a1 + hstep, voffA);
            PG8_WAIT_L(8); PG8_BAR; PG8_WAIT_L(0); PG8_MMA(0, 0, At, B0); PG8_BAR; PG8_SCHED;
            PG8_LDB(B1, 0, 1); PG8_STAGE(PG8_SB(0, 0), b2, voffB);
            PG8_BAR; PG8_WAIT_L(0); PG8_MMA(0, 1, At, B1); PG8_BAR;
            PG8_LDA(At, 0, 1); PG8_STAGE(PG8_SA(0, 0), a2, voffA);
            PG8_BAR; PG8_WAIT_L(0); PG8_MMA(1, 0, At, B0); PG8_BAR; PG8_SCHED;
            PG8_STAGE(PG8_SB(0, 1), b2 + hstep, voffB);
            PG8_WAIT_V(6); PG8_BAR; PG8_MMA(1, 1, At, B1); PG8_BAR;
            PG8_LDB(B0, 1, 0); PG8_SCHED; PG8_LDA(At, 1, 0); PG8_STAGE(PG8_SA(0, 1), a2 + hstep, voffA);
            PG8_WAIT_L(8); PG8_BAR; PG8_WAIT_L(0); PG8_MMA(0, 0, At, B0); PG8_BAR; PG8_SCHED;
            PG8_LDB(B1, 1, 1); PG8_STAGE(PG8_SB(1, 0), b3, voffB);
            PG8_BAR; PG8_WAIT_L(0); PG8_MMA(0, 1, At, B1); PG8_BAR;
            PG8_LDA(At, 1, 1); PG8_STAGE(PG8_SA(1, 0), a3, voffA);
            PG8_BAR; PG8_WAIT_L(0); PG8_MMA(1, 0, At, B0); PG8_BAR; PG8_SCHED;
            PG8_STAGE(PG8_SB(1, 1), b3 + hstep, voffB);
            PG8_WAIT_V(6); PG8_BAR; PG8_MMA(1, 1, At, B1); PG8_BAR;
            }
        }
        if constexpr (ALIGN_EPI) { if (wr == 0) PG8_BAR; }
        if constexpr (!Epi::AFTER_DRAIN) { E(acc, cur, wr, wc, fr, fq); S.done(cur); }
        if (!has_next) break;
#pragma unroll
        for (int a = 0; a < 2; ++a)
#pragma unroll
            for (int b = 0; b < 2; ++b)
#pragma unroll
                for (int m = 0; m < 4; ++m)
#pragma unroll
                    for (int n = 0; n < 2; ++n) acc[a][b][m][n] = (f32x4){0.f, 0.f, 0.f, 0.f};
        cur = nxt; cA = nA; cB = nB; ++ui;
        if constexpr (ALIGN_EPI) { if (wr == 1) PG8_BAR; }
    }
    PG8_WAIT_V(0);
    if constexpr (!ALIGN_EPI) { if (wr == 0) PG8_BAR; }
    PG8_BAR;
    if constexpr (Epi::AFTER_DRAIN) { E.fused(acc, cur, wr, wc, fr, fq, lds, wid, lane); S.done(cur); }
#undef PG8_SA
#undef PG8_SB
#undef PG8_STAGE
#undef PG8_LDA
#undef PG8_LDB
#undef PG8_MMA
#undef PG8_WAIT_V
#undef PG8_WAIT_L
#undef PG8_BAR
#undef PG8_SCHED
}
}
#ifndef FUSE_FINAL
#define FUSE_FINAL 0
#endif
#ifndef PP_IN_P1
#define PP_IN_P1 0
#endif
#ifndef SMALL_REP
#define SMALL_REP 1
#endif

using pg8::bf16x8; using pg8::f32x4; using pg8::u32x4;
typedef unsigned short bf16;
typedef float f32x16 __attribute__((ext_vector_type(16)));
typedef float f32x2_t __attribute__((ext_vector_type(2)));
typedef __bf16 bf16x2_t __attribute__((ext_vector_type(2)));
typedef unsigned u32x2 __attribute__((ext_vector_type(2)));
#define DI __device__ __forceinline__
#define MFMA32(a, b, c) __builtin_amdgcn_mfma_f32_32x32x16_bf16((a), (b), (c), 0, 0, 0)

constexpr int DM = 1024, MP = 16384, MS = 256, MT = MP + MS, NPROJ = 2816, DFF = 4096, PLE = 256, WIN_LD = 2824;
constexpr float EPS = 1e-6f;
constexpr int C_QM = 0, C_KM = 512, C_VM = 1024, C_OM = 1536, C_QA = 2048, C_KA = 2560, C_VA = 2688;

constexpr size_t MiB = (size_t)1 << 20;
constexpr size_t WS_GATES = 0;
constexpr size_t WS_BAR = 540672;
constexpr size_t WS_NST = 589824;
constexpr size_t WS_DN = WS_NST + 524288;
constexpr size_t WS_CHST = WS_DN + 524288;
constexpr size_t WS_MST = WS_CHST + 8192;
constexpr size_t WS_CNT = WS_MST + 4096;
constexpr size_t WS_WIN = 2 * MiB;
constexpr size_t WS_WOUT = WS_WIN + (size_t)NPROJ * DM * 2;
constexpr size_t WS_WUP = WS_WOUT + 2 * MiB;
constexpr size_t WS_WDOWN = WS_WUP + 8 * MiB;
constexpr size_t WS_WGATE = WS_WDOWN + 8 * MiB;
constexpr size_t WS_WPP = WS_WGATE + 2 * MiB;
constexpr size_t WS_H1 = 28 * MiB;
constexpr size_t WS_PROJ = 60 * MiB + MiB / 2;
constexpr size_t WS_DC = 150 * MiB;
constexpr size_t WS_CT = 214 * MiB;
constexpr size_t WS_PB = 246 * MiB;
constexpr size_t WS_U = WS_PROJ;
constexpr size_t WS_X1B = 191 * MiB;
constexpr size_t WS_PP = WS_PROJ;
constexpr size_t WS_SSQA = 224 * MiB;
constexpr size_t WS_SSQB = 226 * MiB;
static_assert(WS_WPP + (size_t)DM * PLE * 2 <= WS_H1 && WS_H1 + (size_t)MT * DM * 2 <= WS_PROJ && WS_PROJ + (size_t)MT * NPROJ * 2 <= WS_DC, "ws map");
static_assert(WS_U + (size_t)MT * DFF * 2 <= WS_X1B && WS_X1B + (size_t)MT * DM * 2 <= WS_SSQA && WS_PB + (size_t)MT * PLE * 2 <= 256 * MiB && WS_CNT + 32768 <= WS_WIN, "ws map 2");

constexpr size_t O_YP = 0, O_YS = 16777216, O_PK = 17039360, O_PV = 17072128, O_PC = 17104896, O_PN = 17235968, O_PM = 17236992,
                 O_SK = 17237000, O_SV = 17368072, O_SC = 17499144, O_SN = 18023432, O_SM = 18027528;

constexpr int LDS_BYTES = 147456;

struct Params { const float* in[23]; float* out; unsigned char* ws; int ph_lo, ph_hi; };

DI unsigned pk2(float lo, float hi) { f32x2_t v = {lo, hi}; bf16x2_t b = __builtin_convertvector(v, bf16x2_t); return __builtin_bit_cast(unsigned, b); }
DI float bflo(unsigned w) { return __uint_as_float(w << 16); }
DI float bfhi(unsigned w) { return __uint_as_float(w & 0xffff0000u); }
DI float bf2f(bf16 h) { return __uint_as_float((unsigned)h << 16); }
DI float wave_sum(float v) {
#pragma unroll
    for (int o = 1; o < 64; o <<= 1) v += __shfl_xor(v, o);
    return v;
}
DI float wave_max(float v) {
#pragma unroll
    for (int o = 1; o < 64; o <<= 1) v = fmaxf(v, __shfl_xor(v, o));
    return v;
}
DI float wave_scan_add(float v, int lane) {
#pragma unroll
    for (int o = 1; o < 64; o <<= 1) { float t = __shfl_up(v, o); if (lane >= o) v += t; }
    return v;
}
DI float wave_scan_max(float v, int lane) {
#pragma unroll
    for (int o = 1; o < 64; o <<= 1) { float t = __shfl_up(v, o); if (lane >= o) v = fmaxf(v, t); }
    return v;
}
DI unsigned elem8(const u32x4& w, int j) { const unsigned lo = (j & 2) ? w.y : w.x, hi = (j & 2) ? w.w : w.z; const unsigned d = (j & 4) ? hi : lo; return (j & 1) ? (d >> 16) : (d & 0xffffu); }
typedef short v4i16_t __attribute__((ext_vector_type(4)));
DI bf16x8 tr_frag2(const bf16* base, int pitch, int klo, int khi, int n0, int lane) {
    const int blk = (lane >> 4) & 1, q = (lane & 15) >> 2, p = lane & 3;
    const bf16* a0 = base + (klo + q) * pitch + n0 + 16 * blk + 4 * p; const bf16* a1 = base + (khi + q) * pitch + n0 + 16 * blk + 4 * p;
    const v4i16_t lo = __builtin_amdgcn_ds_read_tr16_b64_v4i16((__attribute__((address_space(3))) v4i16_t*)a0);
    const v4i16_t hi = __builtin_amdgcn_ds_read_tr16_b64_v4i16((__attribute__((address_space(3))) v4i16_t*)a1);
    bf16x8 r; r[0] = lo[0]; r[1] = lo[1]; r[2] = lo[2]; r[3] = lo[3]; r[4] = hi[0]; r[5] = hi[1]; r[6] = hi[2]; r[7] = hi[3]; return r;
}
DI bf16x8 tr_frag(const bf16* base, int pitch, int k0, int n0, int lane) { const int h = lane >> 5; return tr_frag2(base, pitch, k0 + 8 * h, k0 + 8 * h + 4, n0, lane); }
DI float sigmoidf_(float x) { return 1.f / (1.f + __expf(-x)); }
DI float dot4(f32x4 a) { return (a.x * a.x + a.y * a.y) + (a.z * a.z + a.w * a.w); }

struct EpiStore {
    static constexpr bool PERM = true, AFTER_DRAIN = false;
    bf16* O; int ldc;
    DI void operator()(const f32x4 (&acc)[2][2][4][2], const pg8::Unit& u, int wr, int wc, int fr, int fq) const {
        const int row0 = u.pm * 256 + wr * 64 + fr, col0 = u.pn * 256 + wc * 32 + 8 * fq;
#pragma unroll
        for (int ai = 0; ai < 2; ++ai)
#pragma unroll
            for (int m = 0; m < 4; ++m) { bf16* rowp = O + (size_t)(row0 + ai * 128 + m * 16) * ldc + col0;
#pragma unroll
                for (int bj = 0; bj < 2; ++bj) { const f32x4 v0 = acc[ai][bj][m][0], v1 = acc[ai][bj][m][1];
                    u32x4 w; w.x = pk2(v0[0], v0[1]); w.y = pk2(v0[2], v0[3]); w.z = pk2(v1[0], v1[1]); w.w = pk2(v1[2], v1[3]);
                    *(u32x4*)(rowp + bj * 128) = w; } }
    }
};
template <bool XBF> struct EpiResid {
    static constexpr bool PERM = true, AFTER_DRAIN = false;
    const float* xp; const bf16* xb; bf16* XB; float* ssq;
    DI void operator()(const f32x4 (&acc)[2][2][4][2], const pg8::Unit& u, int wr, int wc, int fr, int fq) const {
        const int row0 = u.pm * 256 + wr * 64 + fr, col0 = u.pn * 256 + wc * 32 + 8 * fq;
#pragma unroll
        for (int ai = 0; ai < 2; ++ai)
#pragma unroll
            for (int m = 0; m < 4; ++m) { const int row = row0 + ai * 128 + m * 16;
                bf16* bp = XB + (size_t)row * DM + col0; float s = 0.f;
#pragma unroll
                for (int bj = 0; bj < 2; ++bj) { f32x4 r0, r1;
                    if (XBF) { const u32x4 pw = *(const u32x4*)(xb + (size_t)row * DM + col0 + bj * 128);
                        r0 = (f32x4){bflo(pw.x), bfhi(pw.x), bflo(pw.y), bfhi(pw.y)}; r1 = (f32x4){bflo(pw.z), bfhi(pw.z), bflo(pw.w), bfhi(pw.w)}; }
                    else { const float* xin = xp + (size_t)row * DM + col0 + bj * 128; r0 = *(const f32x4*)xin; r1 = *(const f32x4*)(xin + 4); }
                    const f32x4 v0 = acc[ai][bj][m][0] + r0, v1 = acc[ai][bj][m][1] + r1;
                    u32x4 w; w.x = pk2(v0[0], v0[1]); w.y = pk2(v0[2], v0[3]); w.z = pk2(v1[0], v1[1]); w.w = pk2(v1[2], v1[3]);
                    *(u32x4*)(bp + bj * 128) = w; s += dot4(v0) + dot4(v1); }
                s += __shfl_xor(s, 16); s += __shfl_xor(s, 32);
                if (fq == 0) ssq[(size_t)row * 16 + u.pn * 4 + wc] = s; }
    }
};
DI float row_rstd(const float* ssq, int row) {
    const f32x4* sp = (const f32x4*)(ssq + (size_t)row * 16);
    const f32x4 t = (sp[0] + sp[1]) + (sp[2] + sp[3]);
    return rsqrtf(((t.x + t.y) + (t.z + t.w)) * (1.f / DM) + EPS);
}
struct EpiUp {
    static constexpr bool PERM = true, AFTER_DRAIN = false;
    bf16* U; const float* ssq;
    DI void operator()(const f32x4 (&acc)[2][2][4][2], const pg8::Unit& u, int wr, int wc, int fr, int fq) const {
        const int row0 = u.pm * 256 + wr * 64 + fr, col0 = u.pn * 256 + wc * 32 + 8 * fq;
#pragma unroll
        for (int ai = 0; ai < 2; ++ai)
#pragma unroll
            for (int m = 0; m < 4; ++m) { const int row = row0 + ai * 128 + m * 16; const float rs = row_rstd(ssq, row);
                bf16* bp = U + (size_t)row * DFF + col0;
#pragma unroll
                for (int bj = 0; bj < 2; ++bj) { f32x4 v0 = acc[ai][bj][m][0] * rs, v1 = acc[ai][bj][m][1] * rs;
#pragma unroll
                    for (int e = 0; e < 4; ++e) { const float a = fmaxf(v0[e], 0.f), b = fmaxf(v1[e], 0.f); v0[e] = a * a; v1[e] = b * b; }
                    u32x4 w; w.x = pk2(v0[0], v0[1]); w.y = pk2(v0[2], v0[3]); w.z = pk2(v1[0], v1[1]); w.w = pk2(v1[2], v1[3]);
                    *(u32x4*)(bp + bj * 128) = w; } }
    }
};
struct EpiPle {
    static constexpr bool PERM = true, AFTER_DRAIN = false;
    const bf16* X2; const bf16* PP; bf16* X3; const float* ssq_in; float* ssq_out;
    DI void operator()(const f32x4 (&acc)[2][2][4][2], const pg8::Unit& u, int wr, int wc, int fr, int fq) const {
        const int row0 = u.pm * 256 + wr * 64 + fr, col0 = u.pn * 256 + wc * 32 + 8 * fq;
#pragma unroll
        for (int ai = 0; ai < 2; ++ai)
#pragma unroll
            for (int m = 0; m < 4; ++m) { const int row = row0 + ai * 128 + m * 16; const float rs = row_rstd(ssq_in, row);
                const size_t off = (size_t)row * DM + col0; float s = 0.f;
#pragma unroll
                for (int bj = 0; bj < 2; ++bj) { const u32x4 xw = *(const u32x4*)(X2 + off + bj * 128), pw = *(const u32x4*)(PP + off + bj * 128);
                    const f32x4 r0 = {bflo(xw.x), bfhi(xw.x), bflo(xw.y), bfhi(xw.y)}, r1 = {bflo(xw.z), bfhi(xw.z), bflo(xw.w), bfhi(xw.w)};
                    const f32x4 p0 = {bflo(pw.x), bfhi(pw.x), bflo(pw.y), bfhi(pw.y)}, p1 = {bflo(pw.z), bfhi(pw.z), bflo(pw.w), bfhi(pw.w)};
                    f32x4 v0, v1;
#pragma unroll
                    for (int e = 0; e < 4; ++e) { v0[e] = r0[e] + sigmoidf_(acc[ai][bj][m][0][e] * rs) * p0[e]; v1[e] = r1[e] + sigmoidf_(acc[ai][bj][m][1][e] * rs) * p1[e]; }
                    u32x4 w; w.x = pk2(v0[0], v0[1]); w.y = pk2(v0[2], v0[3]); w.z = pk2(v1[0], v1[1]); w.w = pk2(v1[2], v1[3]);
                    *(u32x4*)(X3 + off + bj * 128) = w; s += dot4(v0) + dot4(v1); }
                s += __shfl_xor(s, 16); s += __shfl_xor(s, 32);
                if (fq == 0) ssq_out[(size_t)row * 16 + u.pn * 4 + wc] = s; }
    }
};


struct EpiPleNorm {
    static constexpr bool PERM = true, AFTER_DRAIN = false;
    const bf16* X2; const bf16* PP; float* out; const float* ssq_in; float* ssq_out; unsigned* cnt; const float* gf;
    DI void operator()(f32x4 (&acc)[2][2][4][2], const pg8::Unit& u, int wr, int wc, int fr, int fq) const {
        const int row0 = u.pm * 256 + wr * 64 + fr, col0 = u.pn * 256 + wc * 32 + 8 * fq;
#pragma unroll
        for (int ai = 0; ai < 2; ++ai)
#pragma unroll
            for (int m = 0; m < 4; ++m) { const int row = row0 + ai * 128 + m * 16; const float rs = row_rstd(ssq_in, row);
                const size_t off = (size_t)row * DM + col0; float s = 0.f;
#pragma unroll
                for (int bj = 0; bj < 2; ++bj) { const u32x4 xw = *(const u32x4*)(X2 + off + bj * 128), pw = *(const u32x4*)(PP + off + bj * 128);
                    const f32x4 r0 = {bflo(xw.x), bfhi(xw.x), bflo(xw.y), bfhi(xw.y)}, r1 = {bflo(xw.z), bfhi(xw.z), bflo(xw.w), bfhi(xw.w)};
                    const f32x4 p0 = {bflo(pw.x), bfhi(pw.x), bflo(pw.y), bfhi(pw.y)}, p1 = {bflo(pw.z), bfhi(pw.z), bflo(pw.w), bfhi(pw.w)};
                    f32x4 v0, v1;
#pragma unroll
                    for (int e = 0; e < 4; ++e) { v0[e] = r0[e] + sigmoidf_(acc[ai][bj][m][0][e] * rs) * p0[e]; v1[e] = r1[e] + sigmoidf_(acc[ai][bj][m][1][e] * rs) * p1[e]; }
                    acc[ai][bj][m][0] = v0; acc[ai][bj][m][1] = v1; s += dot4(v0) + dot4(v1); }
                s += __shfl_xor(s, 16); s += __shfl_xor(s, 32);
                if (fq == 0) __hip_atomic_store(ssq_out + (size_t)row * 16 + u.pn * 4 + wc, s, __ATOMIC_RELAXED, __HIP_MEMORY_SCOPE_AGENT); }
        asm volatile("s_waitcnt vmcnt(0)" ::: "memory");
        unsigned* c = cnt + 64 * u.pm;
        if ((threadIdx.x & 63) == 0) (void)__hip_atomic_fetch_add(c, 1u, __ATOMIC_RELAXED, __HIP_MEMORY_SCOPE_AGENT);
        { unsigned sp = 0; while (__hip_atomic_load(c, __ATOMIC_RELAXED, __HIP_MEMORY_SCOPE_AGENT) < 32u) { __builtin_amdgcn_s_sleep(2); if (++sp > (1u << 22)) break; } }
        asm volatile("" ::: "memory");
#pragma unroll
        for (int ai = 0; ai < 2; ++ai)
#pragma unroll
            for (int m = 0; m < 4; ++m) { const int row = row0 + ai * 128 + m * 16;
                const unsigned* sp4 = (const unsigned*)(ssq_out + (size_t)row * 16 + fq * 4);
                float t = (__uint_as_float(__hip_atomic_load(sp4, __ATOMIC_RELAXED, __HIP_MEMORY_SCOPE_AGENT)) + __uint_as_float(__hip_atomic_load(sp4 + 1, __ATOMIC_RELAXED, __HIP_MEMORY_SCOPE_AGENT)))
                        + (__uint_as_float(__hip_atomic_load(sp4 + 2, __ATOMIC_RELAXED, __HIP_MEMORY_SCOPE_AGENT)) + __uint_as_float(__hip_atomic_load(sp4 + 3, __ATOMIC_RELAXED, __HIP_MEMORY_SCOPE_AGENT)));
                t += __shfl_xor(t, 16); t += __shfl_xor(t, 32);
                const float rs = rsqrtf(t * (1.f / DM) + EPS);
                float* op = out + (size_t)row * DM + col0;
#pragma unroll
                for (int bj = 0; bj < 2; ++bj) { const f32x4 g0 = *(const f32x4*)(gf + col0 + bj * 128), g1 = *(const f32x4*)(gf + col0 + bj * 128 + 4);
                    *(f32x4*)(op + bj * 128) = acc[ai][bj][m][0] * rs * g0; *(f32x4*)(op + bj * 128 + 4) = acc[ai][bj][m][1] * rs * g1; } }
    }
};

struct SEpiStore { bf16* O; int ldc;
    DI void operator()(int row, int col, f32x4 v, int ct) const { u32x2 w; w.x = pk2(v.x, v.y); w.y = pk2(v.z, v.w); *(u32x2*)(O + (size_t)row * ldc + col) = w; } };
template <bool XBF> struct SEpiResid { const float* xs; const bf16* xb; bf16* XB; float* ssq;
    DI void operator()(int row, int col, f32x4 v, int ct) const {
        if (XBF) { const u32x2 pw = *(const u32x2*)(xb + (size_t)row * DM + col); v = v + (f32x4){bflo(pw.x), bfhi(pw.x), bflo(pw.y), bfhi(pw.y)}; }
        else v = v + *(const f32x4*)(xs + (size_t)(row - MP) * DM + col);
        u32x2 w; w.x = pk2(v.x, v.y); w.y = pk2(v.z, v.w); *(u32x2*)(XB + (size_t)row * DM + col) = w;
        float s = dot4(v); s += __shfl_xor(s, 1); s += __shfl_xor(s, 2); s += __shfl_xor(s, 4); s += __shfl_xor(s, 8);
        if ((threadIdx.x & 15) == 0) ssq[(size_t)row * 16 + ct] = s; } };
struct SEpiUp { bf16* U; const float* ssq;
    DI void operator()(int row, int col, f32x4 v, int ct) const { const float rs = row_rstd(ssq, row);
#pragma unroll
        for (int e = 0; e < 4; ++e) { const float a = fmaxf(v[e] * rs, 0.f); v[e] = a * a; }
        u32x2 w; w.x = pk2(v.x, v.y); w.y = pk2(v.z, v.w); *(u32x2*)(U + (size_t)row * DFF + col) = w; } };
struct SEpiPle { const bf16* X2; const bf16* PP; bf16* X3; const float* ssq_in; float* ssq_out;
    DI void operator()(int row, int col, f32x4 v, int ct) const { const float rs = row_rstd(ssq_in, row);
        const size_t off = (size_t)row * DM + col; const u32x2 xw = *(const u32x2*)(X2 + off), pw = *(const u32x2*)(PP + off);
        const f32x4 r = {bflo(xw.x), bfhi(xw.x), bflo(xw.y), bfhi(xw.y)}, pp = {bflo(pw.x), bfhi(pw.x), bflo(pw.y), bfhi(pw.y)}; f32x4 o;
#pragma unroll
        for (int e = 0; e < 4; ++e) o[e] = r[e] + sigmoidf_(v[e] * rs) * pp[e];
        __hip_atomic_store((unsigned long long*)(X3 + off), (unsigned long long)pk2(o.x, o.y) | ((unsigned long long)pk2(o.z, o.w) << 32), __ATOMIC_RELAXED, __HIP_MEMORY_SCOPE_AGENT);
        float s = dot4(o); s += __shfl_xor(s, 1); s += __shfl_xor(s, 2); s += __shfl_xor(s, 4); s += __shfl_xor(s, 8);
        if ((threadIdx.x & 15) == 0) __hip_atomic_store(ssq_out + (size_t)row * 16 + ct, s, __ATOMIC_RELAXED, __HIP_MEMORY_SCOPE_AGENT); } };
template <int K, class Epi, bool FINAL = false> DI void small_gemm(const bf16* A, const bf16* Bt, int N, unsigned char* lds, int bid, int G, const Epi& E, unsigned* cnt = nullptr, const float* gf = nullptr, float* yout = nullptr) {
    const int tid = threadIdx.x, lane = tid & 63, wave = tid >> 6, ql = lane & 31, half = lane >> 5;
    float* red = (float*)lds;
    constexpr int KW = K / 8, CH = KW >= 128 ? 128 : KW, NS = CH / 16;
    const int ntiles = 8 * (N / 64);
    for (int t = bid; t < ntiles; t += G) {
        const int rt = t & 7, ct = t >> 3;
        const bf16* ap = A + (size_t)(MP + rt * 32 + ql) * K + wave * KW + half * 8;
        const bf16* bp0 = Bt + (size_t)(ct * 64 + ql) * K + wave * KW + half * 8; const bf16* bp1 = bp0 + (size_t)32 * K;
        f32x16 c0, c1;
#pragma unroll
        for (int r = 0; r < 16; ++r) { c0[r] = 0.f; c1[r] = 0.f; }
#pragma unroll 1
        for (int k = 0; k < KW; k += CH) {
            bf16x8 a[NS], b0[NS], b1[NS];
#pragma unroll
            for (int i = 0; i < NS; ++i) { a[i] = *(const bf16x8*)(ap + k + 16 * i); b0[i] = *(const bf16x8*)(bp0 + k + 16 * i); b1[i] = *(const bf16x8*)(bp1 + k + 16 * i); }
#pragma unroll
            for (int i = 0; i < NS; ++i) { c0 = MFMA32(a[i], b0[i], c0); c1 = MFMA32(a[i], b1[i], c1); } }
#pragma unroll
        for (int r = 0; r < 16; ++r) { red[((wave * 2 + 0) * 16 + r) * 64 + lane] = c0[r]; red[((wave * 2 + 1) * 16 + r) * 64 + lane] = c1[r]; }
        __syncthreads();
        { const int row = tid >> 4, col = (tid & 15) * 4, j = col >> 5, cq = col & 31, hh = (row >> 2) & 1, r = (row & 3) + 4 * (row >> 3);
          f32x4 v = {0.f, 0.f, 0.f, 0.f};
#pragma unroll
          for (int w = 0; w < 8; ++w) v = v + *(const f32x4*)(red + ((w * 2 + j) * 16 + r) * 64 + hh * 32 + cq);
          E(MP + rt * 32 + row, ct * 64 + col, v, ct); }
        if constexpr (FINAL) {
            asm volatile("s_waitcnt vmcnt(0)" ::: "memory");
            __syncthreads();
            unsigned* flag = (unsigned*)(lds + 65536);
            if (tid == 0) *flag = __hip_atomic_fetch_add(cnt + 64 * (64 + rt), 1u, __ATOMIC_RELAXED, __HIP_MEMORY_SCOPE_AGENT);
            __syncthreads();
            if (*flag == 15u) {
                __builtin_amdgcn_fence(__ATOMIC_ACQUIRE, "agent");
                asm volatile("s_waitcnt vmcnt(0)" ::: "memory");
#pragma unroll 1
                for (int rr = 0; rr < 4; ++rr) { const int row = MP + rt * 32 + wave * 4 + rr; const float rs = row_rstd(E.ssq_out, row);
#pragma unroll
                    for (int j = 0; j < 2; ++j) { const u32x4 xw = *(const u32x4*)(E.X3 + (size_t)row * DM + lane * 8 + 512 * j);
                        const f32x4 g0 = *(const f32x4*)(gf + lane * 8 + 512 * j), g1 = *(const f32x4*)(gf + lane * 8 + 512 * j + 4);
                        *(f32x4*)(yout + (size_t)row * DM + lane * 8 + 512 * j) = (f32x4){bflo(xw.x), bfhi(xw.x), bflo(xw.y), bfhi(xw.y)} * rs * g0;
                        *(f32x4*)(yout + (size_t)row * DM + lane * 8 + 512 * j + 4) = (f32x4){bflo(xw.z), bfhi(xw.z), bflo(xw.w), bfhi(xw.w)} * rs * g1; } } }
        }
        __syncthreads();
    }
}

DI void tr_item(const float* W, int ldw, int K, bf16* Wt, const float* gk, int k0, int n0, int nsrc0, float nsc, float* tt, int tid) {
    f32x4 v[4][2]; float g[2];
#pragma unroll
    for (int i = 0; i < 2; ++i) { const int kk = (tid >> 4) + 32 * i, c4 = (tid & 15) * 4;
#pragma unroll
        for (int sub = 0; sub < 4; ++sub) v[sub][i] = *(const f32x4*)(W + (size_t)(k0 + kk) * ldw + nsrc0 + sub * 64 + c4);
        g[i] = (gk ? gk[k0 + kk] : 1.f) * nsc; }
#pragma unroll
    for (int i = 0; i < 2; ++i) { const int kk = (tid >> 4) + 32 * i, c4 = (tid & 15) * 4;
#pragma unroll
        for (int sub = 0; sub < 4; ++sub) { float* d = tt + sub * 4160 + kk * 65 + c4; d[0] = v[sub][i].x * g[i]; d[1] = v[sub][i].y * g[i]; d[2] = v[sub][i].z * g[i]; d[3] = v[sub][i].w * g[i]; } }
    __syncthreads();
    { const int n = tid >> 3, kc = (tid & 7) * 8;
#pragma unroll
      for (int sub = 0; sub < 4; ++sub) { const float* s = tt + sub * 4160 + kc * 65 + n;
          u32x4 o; o.x = pk2(s[0], s[65]); o.y = pk2(s[2 * 65], s[3 * 65]); o.z = pk2(s[4 * 65], s[5 * 65]); o.w = pk2(s[6 * 65], s[7 * 65]);
          *(u32x4*)(Wt + (size_t)(n0 + sub * 64 + n) * K + k0 + kc) = o; } }
    __syncthreads();
}
DI void p0_weights(const Params& P, float* tt, int bid, int G) {
    const int tid = threadIdx.x, lane = tid & 63, wave = tid >> 6; unsigned char* ws = P.ws; (void)lane; (void)wave;
    const float* w_in = P.in[10];
    constexpr int T_IN = 16 * 11, T_OUT = 16 * 4, T_UP = 16 * 16, T_DOWN = 64 * 4, T_GATE = 16 * 4, T_PP = 4 * 4;
    constexpr int T_ALL = T_IN + T_OUT + T_UP + T_DOWN + T_GATE + T_PP;
    for (int it = bid; it < T_ALL; it += G) {
        int r = it;
        if (r < T_IN) { const int kb = r / 11, nb = r % 11, n0 = nb * 256;
            const float nsc = (n0 >= C_KM && n0 < C_VM) ? 0.08838834764831845f : ((n0 >= C_QA && n0 < C_KA) ? 0.125f : 1.f);
            tr_item(w_in, WIN_LD, DM, (bf16*)(ws + WS_WIN), nullptr, kb * 64, n0, n0 + (n0 >= 2048 ? 8 : 0), nsc, tt, tid); continue; } r -= T_IN;
        if (r < T_OUT) { tr_item(P.in[15], DM, DM, (bf16*)(ws + WS_WOUT), nullptr, (r / 4) * 64, (r % 4) * 256, (r % 4) * 256, 1.f, tt, tid); continue; } r -= T_OUT;
        if (r < T_UP) { tr_item(P.in[17], DFF, DM, (bf16*)(ws + WS_WUP), P.in[16], (r / 16) * 64, (r % 16) * 256, (r % 16) * 256, 1.f, tt, tid); continue; } r -= T_UP;
        if (r < T_DOWN) { tr_item(P.in[18], DM, DFF, (bf16*)(ws + WS_WDOWN), nullptr, (r / 4) * 64, (r % 4) * 256, (r % 4) * 256, 1.f, tt, tid); continue; } r -= T_DOWN;
        if (r < T_GATE) { tr_item(P.in[20], DM, DM, (bf16*)(ws + WS_WGATE), P.in[19], (r / 4) * 64, (r % 4) * 256, (r % 4) * 256, 1.f, tt, tid); continue; } r -= T_GATE;
        tr_item(P.in[21], DM, PLE, (bf16*)(ws + WS_WPP), nullptr, (r / 4) * 64, (r % 4) * 256, (r % 4) * 256, 1.f, tt, tid);
    }
}
DI void p0_rows(const Params& P, const float* wgT, int bid, int G) {
    const int tid = threadIdx.x, lane = tid & 63, wave = tid >> 6; unsigned char* ws = P.ws; (void)lane; (void)wave;
    const float* g_mix = P.in[9]; bf16* H1 = (bf16*)(ws + WS_H1); float* GT = (float*)(ws + WS_GATES);
    const f32x4 bi = *(const f32x4*)P.in[11], bf_ = *(const f32x4*)P.in[12];
    for (int it = G - 1 - bid; it < MT / 16; it += G) {
        f32x4 vv[2][4];
#pragma unroll
        for (int rr = 0; rr < 2; ++rr) { const int row = it * 16 + rr * 8 + wave;
            const float* xr = row < MP ? P.in[0] + (size_t)row * DM : P.in[1] + (size_t)(row - MP) * DM;
#pragma unroll
            for (int j = 0; j < 4; ++j) vv[rr][j] = *(const f32x4*)(xr + lane * 4 + 256 * j); }
#pragma unroll
        for (int rr = 0; rr < 2; ++rr) { const int row = it * 16 + rr * 8 + wave; float s = 0.f;
#pragma unroll
        for (int j = 0; j < 4; ++j) s += dot4(vv[rr][j]);
        const float rstd = rsqrtf(wave_sum(s) * (1.f / DM) + EPS);
        float ga[8];
#pragma unroll
        for (int c = 0; c < 8; ++c) ga[c] = 0.f;
#pragma unroll
        for (int j = 0; j < 4; ++j) { const f32x4 g = *(const f32x4*)(g_mix + lane * 4 + 256 * j);
            f32x4 h = vv[rr][j] * rstd * g;
            u32x2 o; o.x = pk2(h.x, h.y); o.y = pk2(h.z, h.w);
            *(u32x2*)(H1 + (size_t)row * DM + lane * 4 + 256 * j) = o;
#pragma unroll
            for (int c = 0; c < 8; ++c) { const f32x4 w = *(const f32x4*)(wgT + c * 1024 + lane * 4 + 256 * j); ga[c] += (h.x * w.x + h.y * w.y) + (h.z * w.z + h.w * w.w); } }
#pragma unroll
        for (int c = 0; c < 8; ++c) ga[c] = wave_sum(ga[c]);
        if (lane == 0) {
            f32x4 iv = {ga[0] + bi.x, ga[1] + bi.y, ga[2] + bi.z, ga[3] + bi.w};
            f32x4 fv = {ga[4] + bf_.x, ga[5] + bf_.y, ga[6] + bf_.z, ga[7] + bf_.w};
#pragma unroll
            for (int e = 0; e < 4; ++e) fv[e] = fminf(fv[e], 0.f) - log1pf(__expf(-fabsf(fv[e])));
            *(f32x4*)(GT + (size_t)row * 8) = iv; *(f32x4*)(GT + (size_t)row * 8 + 4) = fv; } }
    }
    bf16* PB = (bf16*)(ws + WS_PB);
    for (int it = G - 1 - bid; it < MT * PLE / 4096; it += G) {
        const size_t e = (size_t)it * 4096 + tid * 8;
        const float* src = e < (size_t)MP * PLE ? P.in[7] + e : P.in[8] + (e - (size_t)MP * PLE);
        const f32x4 a = *(const f32x4*)src, b = *(const f32x4*)(src + 4);
        u32x4 o; o.x = pk2(a.x, a.y); o.y = pk2(a.z, a.w); o.z = pk2(b.x, b.y); o.w = pk2(b.z, b.w);
        *(u32x4*)(PB + e) = o;
    }
}
DI void phase0(const Params& P, unsigned char* lds, int bid, int G) {
    const int tid = threadIdx.x, lane = tid & 63, wave = tid >> 6;
    float* wgT = (float*)lds;
    float* tt = (float*)(lds + 32768);
    unsigned char* ws = P.ws;
    const float* w_in = P.in[10];
    for (int k = tid; k < DM; k += 512) {
        const f32x4 a = *(const f32x4*)(w_in + (size_t)k * WIN_LD + 2048), b = *(const f32x4*)(w_in + (size_t)k * WIN_LD + 2052);
        wgT[k] = a.x; wgT[1024 + k] = a.y; wgT[2048 + k] = a.z; wgT[3072 + k] = a.w;
        wgT[4096 + k] = b.x; wgT[5120 + k] = b.y; wgT[6144 + k] = b.z; wgT[7168 + k] = b.w; }
    __syncthreads();
    if (bid & 1) { p0_rows(P, wgT, bid, G); p0_weights(P, tt, bid, G); } else { p0_weights(P, tt, bid, G); p0_rows(P, wgT, bid, G); }
}

DI void dc_item(const Params& P, unsigned char* lds, int it) {
    const int tid = threadIdx.x, lane = tid & 63, wave = tid >> 6, ql = lane & 31, half = lane >> 5;
    constexpr int PT = 160;
    bf16* sV = (bf16*)lds; bf16* sKw = (bf16*)(lds + 20480); float* sw = (float*)(lds + 40960);
    const int cid = it >> 2, h = it & 3, rowbase = cid * 64;
    const bf16* PROJ = (const bf16*)(P.ws + WS_PROJ); const float* GT = (const float*)(P.ws + WS_GATES);
    if (wave == 0) {
        const float iv = GT[(size_t)(rowbase + lane) * 8 + h], lf = GT[(size_t)(rowbase + lane) * 8 + 4 + h];
        const float b = wave_scan_add(lf, lane), B = __shfl(b, 63), e = iv - b, emax = wave_max(e);
        sw[lane] = __expf(e - emax);
        if (lane == 0) { float* CH = (float*)(P.ws + WS_CHST); CH[it * 2] = B; CH[it * 2 + 1] = B + emax; }
    }
    u32x4 kr[2], vr[2];
#pragma unroll
    for (int j = 0; j < 2; ++j) { const int idx = tid + 512 * j, s = idx >> 4, dg = idx & 15;
        const bf16* src = PROJ + (size_t)(rowbase + s) * NPROJ + h * 128 + dg * 8;
        kr[j] = *(const u32x4*)(src + C_KM); vr[j] = *(const u32x4*)(src + C_VM); }
    __syncthreads();
#pragma unroll
    for (int j = 0; j < 2; ++j) { const int idx = tid + 512 * j, s = idx >> 4, dg = idx & 15; const float w = sw[s];
        u32x4 kw;
#pragma unroll
        for (int e = 0; e < 4; ++e) kw[e] = pk2(bflo(kr[j][e]) * w, bfhi(kr[j][e]) * w);
        *(u32x4*)(sKw + s * PT + dg * 8) = kw; *(u32x4*)(sV + s * PT + dg * 8) = vr[j]; }
    __syncthreads();
    const int vt = wave >> 1, dt0 = 2 * (wave & 1);
    f32x16 acc[2];
#pragma unroll
    for (int q = 0; q < 2; ++q)
#pragma unroll
        for (int r = 0; r < 16; ++r) acc[q][r] = 0.f;
#pragma unroll
    for (int kk = 0; kk < 4; ++kk) { const bf16x8 a = tr_frag(sV, PT, kk * 16, vt * 32, lane);
#pragma unroll
        for (int q = 0; q < 2; ++q) { const bf16x8 b = tr_frag(sKw, PT, kk * 16, (dt0 + q) * 32, lane); acc[q] = MFMA32(a, b, acc[q]); } }
    bf16* DC = (bf16*)(P.ws + WS_DC) + (size_t)it * 16384;
#pragma unroll
    for (int q = 0; q < 2; ++q)
#pragma unroll
        for (int r = 0; r < 16; ++r) { const int v = vt * 32 + 8 * (r >> 2) + 4 * half + (r & 3), d = (dt0 + q) * 32 + ql; DC[v * 128 + d] = (bf16)(pk2(acc[q][r], 0.f) & 0xffffu); }
    if (tid < 128) { float s = 0.f;
#pragma unroll 8
        for (int k = 0; k < 64; ++k) s += bf2f(sKw[k * PT + tid]);
        ((float*)(P.ws + WS_DN))[(size_t)it * 128 + tid] = s; }
    __syncthreads();
}

template <bool SAMPLE> DI void attn_item(const Params& P, unsigned char* lds, int item) {
    constexpr int NKT = SAMPLE ? 5 : 6, NK = NKT * 32, VP = 96;
    const int tid = threadIdx.x, lane = tid & 63, wave = tid >> 6, ql = lane & 31, half = lane >> 5;
    bf16* sK = (bf16*)lds;
    bf16* sV = (bf16*)(lds + 27648);
    const bf16* PROJ = (const bf16*)(P.ws + WS_PROJ); bf16* MIX = (bf16*)(P.ws + WS_H1);
    int b, n, kvh;
    if (SAMPLE) { b = item >> 1; kvh = item & 1; n = 0; } else { kvh = item & 1; n = (item >> 1) & 127; b = item >> 8; }
    { u32x4 kq[3], vq[3];
#pragma unroll
      for (int i = 0; i < 3; ++i) { const int c = tid + 512 * i, hi = c >> 8, dg = (c & 3) | ((hi & 1) << 2), s = (hi >> 1) * 64 + ((c >> 2) & 63);
        u32x4 kv = {0u, 0u, 0u, 0u}, vv = {0u, 0u, 0u, 0u};
        if (s < NK) {
        if (SAMPLE) {
            if (s < 128) { const float* ck = P.in[2] + ((size_t)(b * 128 + s) * 2 + kvh) * 64 + dg * 8; const float* cv = P.in[3] + ((size_t)(b * 128 + s) * 2 + kvh) * 64 + dg * 8;
                const f32x4 a0 = *(const f32x4*)ck, a1 = *(const f32x4*)(ck + 4), b0 = *(const f32x4*)cv, b1 = *(const f32x4*)(cv + 4);
                kv.x = pk2(a0.x, a0.y); kv.y = pk2(a0.z, a0.w); kv.z = pk2(a1.x, a1.y); kv.w = pk2(a1.z, a1.w);
                vv.x = pk2(b0.x, b0.y); vv.y = pk2(b0.z, b0.w); vv.z = pk2(b1.x, b1.y); vv.w = pk2(b1.z, b1.w); }
            else { const bf16* src = PROJ + (size_t)(MP + b * 32 + s - 128) * NPROJ + kvh * 64 + dg * 8; kv = *(const u32x4*)(src + C_KA); vv = *(const u32x4*)(src + C_VA); }
        } else { const int tok = 64 * (n - 2) + s;
            if (tok >= 0) { const bf16* src = PROJ + (size_t)(b * 8192 + tok) * NPROJ + kvh * 64 + dg * 8; kv = *(const u32x4*)(src + C_KA); vv = *(const u32x4*)(src + C_VA); } } }
        kq[i] = kv; vq[i] = vv; }
#pragma unroll
      for (int i = 0; i < 3; ++i) { const int c = tid + 512 * i, hi = c >> 8, dgl = c & 3, dg = dgl | ((hi & 1) << 2), s = (hi >> 1) * 64 + ((c >> 2) & 63);
        if (s < NK) { *(u32x4*)(sK + s * 72 + dg * 8) = kq[i]; *(u32x4*)(sV + s * VP + dg * 8) = vq[i]; } } }
    __syncthreads();
    int g, qoff; bool active;
    if (SAMPLE) { g = wave & 3; qoff = 0; active = wave < 4; } else { g = wave >> 1; qoff = 32 * (wave & 1); active = true; }
    if (active) {
        const int qrow = (SAMPLE ? MP + b * 32 : b * 8192 + n * 64) + qoff + ql, head = kvh * 4 + g;
        bf16x8 qf[4];
#pragma unroll
        for (int kk = 0; kk < 4; ++kk) qf[kk] = *(const bf16x8*)(PROJ + (size_t)qrow * NPROJ + C_QA + head * 64 + kk * 16 + half * 8);
        const float slope = exp2f(-(float)(head + 1)), sink = P.in[14][head];
        const int q = qoff + ql, smin = SAMPLE ? 0 : 64 * (2 - n);
        float m_run = sink, den = 0.f;
        f32x16 o[2];
#pragma unroll
        for (int vt = 0; vt < 2; ++vt)
#pragma unroll
            for (int r = 0; r < 16; ++r) o[vt][r] = 0.f;
#pragma unroll 1
        for (int st = 0; st < NKT; ++st) {
            if (st * 32 + 32 <= smin) continue;
            f32x16 sc;
#pragma unroll
            for (int r = 0; r < 16; ++r) sc[r] = 0.f;
#pragma unroll
            for (int kk = 0; kk < 4; ++kk) { const bf16x8 a = *(const bf16x8*)(sK + (st * 32 + ql) * 72 + kk * 16 + half * 8); sc = MFMA32(a, qf[kk], sc); }
            float tm = -INFINITY;
#pragma unroll
            for (int r = 0; r < 16; ++r) { const int s = st * 32 + 8 * (r >> 2) + 4 * half + (r & 3);
                float v = sc[r] - slope * fabsf((float)(128 + q - s)); if (s < smin) v = -INFINITY; sc[r] = v; tm = fmaxf(tm, v); }
            tm = fmaxf(tm, __shfl_xor(tm, 32));
            const float m_new = fmaxf(m_run, tm), alpha = __expf(m_run - m_new); m_run = m_new;
            den *= alpha;
#pragma unroll
            for (int r = 0; r < 16; ++r) { const float p = __expf(sc[r] - m_new); sc[r] = p; den += p; }
#pragma unroll
            for (int vt = 0; vt < 2; ++vt)
#pragma unroll
                for (int r = 0; r < 16; ++r) o[vt][r] *= alpha;
#pragma unroll
            for (int k2 = 0; k2 < 2; ++k2) { u32x4 pw; pw.x = pk2(sc[8 * k2], sc[8 * k2 + 1]); pw.y = pk2(sc[8 * k2 + 2], sc[8 * k2 + 3]);
                pw.z = pk2(sc[8 * k2 + 4], sc[8 * k2 + 5]); pw.w = pk2(sc[8 * k2 + 6], sc[8 * k2 + 7]);
                const bf16x8 bfr = __builtin_bit_cast(bf16x8, pw);
#pragma unroll
                for (int vt = 0; vt < 2; ++vt) { const int klo = st * 32 + k2 * 16 + 4 * half;
                    o[vt] = MFMA32(tr_frag2(sV, VP, klo, klo + 8, vt * 32, lane), bfr, o[vt]); } }
        }
        den += __shfl_xor(den, 32); den += __expf(sink - m_run);
        const float inv = 1.f / den;
        bf16* orow = MIX + (size_t)qrow * DM + 512 + head * 64;
#pragma unroll
        for (int vt = 0; vt < 2; ++vt)
#pragma unroll
            for (int g4 = 0; g4 < 4; ++g4) { u32x2 w; w.x = pk2(o[vt][4 * g4] * inv, o[vt][4 * g4 + 1] * inv); w.y = pk2(o[vt][4 * g4 + 2] * inv, o[vt][4 * g4 + 3] * inv);
                *(u32x2*)(orow + vt * 32 + 8 * g4 + 4 * half) = w; }
    }
    __syncthreads();
}

DI void kvcopy_item(const Params& P, int item) {
    const int e = item * 2048 + threadIdx.x * 4;
    const bf16* PROJ = (const bf16*)(P.ws + WS_PROJ);
    f32x4 v;
    if (e < 65536) { const int isv = e >> 15, idx = e & 32767, b = idx >> 14, w = (idx >> 7) & 127, c = idx & 127;
        const u32x2 pw = *(const u32x2*)(PROJ + (size_t)(b * 8192 + 8064 + w) * NPROJ + (isv ? C_VA : C_KA) + c);
        v = (f32x4){bflo(pw.x), bfhi(pw.x), bflo(pw.y), bfhi(pw.y)};
        *(f32x4*)(P.out + (isv ? O_PV : O_PK) + idx) = v;
    } else { const int e2 = e - 65536, isv = e2 >> 17, idx = e2 & 131071, b = idx >> 14, w = (idx >> 7) & 127, c = idx & 127;
        if (w < 96) v = *(const f32x4*)(P.in[isv ? 3 : 2] + (size_t)(b * 128 + w + 32) * 128 + c);
        else { const u32x2 pw = *(const u32x2*)(PROJ + (size_t)(MP + b * 32 + w - 96) * NPROJ + (isv ? C_VA : C_KA) + c); v = (f32x4){bflo(pw.x), bfhi(pw.x), bflo(pw.y), bfhi(pw.y)}; }
        *(f32x4*)(P.out + (isv ? O_SV : O_SK) + idx) = v; }
}

DI void scan_item(const Params& P, unsigned char* lds, int it) {
    const int tid = threadIdx.x;
    float* sB = (float*)lds; float* sM = sB + 128; float* wc = sB + 256; float* wsc = sB + 384;
    const int bh = it >> 5, part = it & 31, b = bh >> 2, h = bh & 3;
    const float* CH = (const float*)(P.ws + WS_CHST);
    if (tid < 128) { const int item = (b * 128 + tid) * 4 + h; sB[tid] = CH[item * 2]; sM[tid] = CH[item * 2 + 1]; }
    __syncthreads();
    if (tid < 64) {
        const int l = tid; const float B0 = sB[2 * l], M0 = sM[2 * l], B1 = sB[2 * l + 1], M1 = sM[2 * l + 1];
        float cb = B0 + B1, cm = fmaxf(M0 + B1, M1);
#pragma unroll
        for (int o = 1; o < 64; o <<= 1) { const float tb = __shfl_up(cb, o), tm = __shfl_up(cm, o); if (l >= o) { cm = fmaxf(tm + cb, cm); cb = tb + cb; } }
        float xb = __shfl_up(cb, 1), xm = __shfl_up(cm, 1); if (l == 0) { xb = 0.f; xm = -INFINITY; }
        const float ms0 = fmaxf(xb, xm);
        const float ma0 = fmaxf(ms0 + B0, M0), ma1 = fmaxf(ma0 + B1, M1);
        wc[2 * l] = __expf(B0 + ms0 - ma0); wsc[2 * l] = __expf(M0 - ma0); wc[2 * l + 1] = __expf(B1 + ma0 - ma1); wsc[2 * l + 1] = __expf(M1 - ma1);
        if (part == 0) { float* MST = (float*)(P.ws + WS_MST); MST[(b * 128 + 2 * l) * 4 + h] = ms0; MST[(b * 128 + 2 * l + 1) * 4 + h] = ma0;
            if (l == 63) P.out[O_PM + b * 4 + h] = ma1; } }
    __syncthreads();
    const int idx = part * 512 + tid;
    const bf16* DC = (const bf16*)(P.ws + WS_DC) + ((size_t)(b * 128) * 4 + h) * 16384 + idx;
    bf16* CT = (bf16*)(P.ws + WS_CT) + ((size_t)(b * 128) * 4 + h) * 16384 + idx;
    float C = 0.f;
    { float d[32], dn[32], e[32], en[32];
      const bool nthr = tid < 4; const int ne = part * 4 + (tid & 3);
      const float* __restrict__ DN = (const float*)(P.ws + WS_DN) + ((size_t)(b * 128) * 4 + h) * 128 + ne;
      float* __restrict__ NST = (float*)(P.ws + WS_NST) + ((size_t)(b * 128) * 4 + h) * 128 + ne; float nn = 0.f;
#pragma unroll
      for (int j = 0; j < 32; ++j) { d[j] = bf2f(DC[(size_t)j * 65536]); e[j] = nthr ? DN[(size_t)j * 512] : 0.f; }
#pragma unroll 1
      for (int n0 = 0; n0 < 128; n0 += 32) {
          if (n0 + 32 < 128) {
#pragma unroll
              for (int j = 0; j < 32; ++j) { dn[j] = bf2f(DC[(size_t)(n0 + 32 + j) * 65536]); en[j] = nthr ? DN[(size_t)(n0 + 32 + j) * 512] : 0.f; } }
#pragma unroll
          for (int j = 0; j < 32; ++j) { const float w1 = wc[n0 + j], w2 = wsc[n0 + j];
              CT[(size_t)(n0 + j) * 65536] = (bf16)(pk2(C, 0.f) & 0xffffu); C = w1 * C + w2 * d[j];
              if (nthr) NST[(size_t)(n0 + j) * 512] = nn; nn = w1 * nn + w2 * e[j]; }
#pragma unroll
          for (int j = 0; j < 32; ++j) { d[j] = dn[j]; e[j] = en[j]; } }
      if (nthr) P.out[O_PN + (b * 4 + h) * 128 + ne] = nn; }
    { const int v = idx >> 7, d = idx & 127; P.out[O_PC + ((size_t)(b * 4 + h) * 128 + d) * 128 + v] = C; }
    __syncthreads();
}

struct MlR { u32x4 q[2], k[2], v[2], ct[4], om[2]; float nv, gi, glf, mn; };
DI void ml_load(const Params& P, int it, MlR& R) {
    const int tid = threadIdx.x, lane = tid & 63;
    const int cid = it >> 2, h = it & 3, rowbase = cid * 64;
    const bf16* PROJ = (const bf16*)(P.ws + WS_PROJ); const float* GT = (const float*)(P.ws + WS_GATES);
#pragma unroll
    for (int j = 0; j < 2; ++j) { const int idx = tid + 512 * j, s = (idx >> 2) & 63, dg = (idx & 3) | (((idx >> 8) & 3) << 2);
        const bf16* src = PROJ + (size_t)(rowbase + s) * NPROJ + h * 128 + dg * 8;
        R.q[j] = *(const u32x4*)(src + C_QM); R.k[j] = *(const u32x4*)(src + C_KM); R.v[j] = *(const u32x4*)(src + C_VM); }
    { const bf16* CT = (const bf16*)(P.ws + WS_CT) + (size_t)it * 16384;
#pragma unroll
      for (int j = 0; j < 4; ++j) { const int idx = tid + 512 * j, v = idx >> 4, dg = idx & 15; R.ct[j] = *(const u32x4*)(CT + v * 128 + dg * 8); } }
    R.nv = ((const float*)(P.ws + WS_NST))[(size_t)it * 128 + (tid & 127)];
    R.gi = GT[(size_t)(rowbase + lane) * 8 + h]; R.glf = GT[(size_t)(rowbase + lane) * 8 + 4 + h];
    R.mn = ((const float*)(P.ws + WS_MST))[it];
    { const int t = tid >> 3, part = tid & 7; const bf16* om = PROJ + (size_t)(rowbase + t) * NPROJ + C_OM + h * 128 + part * 16;
      R.om[0] = *(const u32x4*)om; R.om[1] = *(const u32x4*)(om + 8); }
}
DI void ml_item(const Params& P, unsigned char* lds, int it, MlR& R, int next_it) {
    const int tid = threadIdx.x, lane = tid & 63, wave = tid >> 6, ql = lane & 31, half = lane >> 5;
    bf16* sQ = (bf16*)lds; bf16* sK = (bf16*)(lds + 17408); bf16* sV = (bf16*)(lds + 34816); bf16* sCt = (bf16*)(lds + 55296);
    bf16* sP = (bf16*)(lds + 90112); float* sH = (float*)(lds + 99328); float* ar = (float*)(lds + 133120);
    float* a_e = ar, *a_mx = ar + 64, *a_wi = ar + 128, *a_enm = ar + 192, *a_qn = ar + 256, *a_scl = ar + 320, *a_nv = ar + 384;
    const int cid = it >> 2, h = it & 3, rowbase = cid * 64;
    const bf16* PROJ = (const bf16*)(P.ws + WS_PROJ); bf16* MIX = (bf16*)(P.ws + WS_H1);
#pragma unroll
    for (int j = 0; j < 2; ++j) { const int idx = tid + 512 * j, s = (idx >> 2) & 63, dg = (idx & 3) | (((idx >> 8) & 3) << 2);
        *(u32x4*)(sQ + s * 136 + dg * 8) = R.q[j];
        *(u32x4*)(sK + s * 136 + dg * 8) = R.k[j];
        *(u32x4*)(sV + s * 160 + dg * 8) = R.v[j]; }
#pragma unroll
    for (int j = 0; j < 4; ++j) { const int idx = tid + 512 * j, v = idx >> 4, dg = idx & 15; *(u32x4*)(sCt + v * 136 + dg * 8) = R.ct[j]; }
    if (tid < 128) a_nv[tid] = R.nv;
    if (wave == 0) {
        const float m_n = R.mn, iv = R.gi, lf = R.glf;
        const float b = wave_scan_add(lf, lane), e = iv - b, pm = wave_scan_max(e, lane), mxv = fmaxf(m_n, pm);
        a_e[lane] = e; a_mx[lane] = mxv; a_wi[lane] = __expf(m_n - mxv); a_enm[lane] = __expf(-(b + mxv));
    }
    const u32x4 om0 = R.om[0], om1 = R.om[1];
    if (next_it >= 0) ml_load(P, next_it, R);
    __syncthreads();
    if (wave < 4) { const int tt = wave >> 1, ss = wave & 1;
        f32x16 acc;
#pragma unroll
        for (int r = 0; r < 16; ++r) acc[r] = 0.f;
        if (!(tt == 0 && ss == 1)) {
#pragma unroll
            for (int kk = 0; kk < 8; ++kk) { const bf16x8 a = *(const bf16x8*)(sQ + (tt * 32 + ql) * 136 + kk * 16 + half * 8), bb = *(const bf16x8*)(sK + (ss * 32 + ql) * 136 + kk * 16 + half * 8);
                acc = MFMA32(a, bb, acc); } }
        const int s = ss * 32 + ql; const float es = a_e[s];
#pragma unroll
        for (int r = 0; r < 16; ++r) { const int t = tt * 32 + 8 * (r >> 2) + 4 * half + (r & 3);
            const float val = (s <= t) ? acc[r] * __expf(es - a_mx[t]) : 0.f;
            sP[t * 72 + s] = (bf16)(pk2(val, 0.f) & 0xffffu); }
    } else { const int idx = tid - 256, t = idx >> 2, part = idx & 3; float s = 0.f;
#pragma unroll 8
        for (int d = 0; d < 32; ++d) s += bf2f(sQ[t * 136 + part * 32 + d]) * a_nv[part * 32 + d];
        s += __shfl_xor(s, 1); s += __shfl_xor(s, 2);
        if (part == 0) a_qn[t] = s; }
    __syncthreads();
    { const int t = tid >> 3, part = tid & 7; const u32x4 pw = *(const u32x4*)(sP + t * 72 + part * 8);
      float s = ((bflo(pw.x) + bfhi(pw.x)) + (bflo(pw.y) + bfhi(pw.y))) + ((bflo(pw.z) + bfhi(pw.z)) + (bflo(pw.w) + bfhi(pw.w)));
      s += __shfl_xor(s, 1); s += __shfl_xor(s, 2); s += __shfl_xor(s, 4);
      if (part == 0) { const float den = s + a_wi[t] * a_qn[t]; a_scl[t] = 1.f / fmaxf(fabsf(den), a_enm[t]); } }
    __syncthreads();
    { const int tt = wave & 1, vc = wave >> 1;
      f32x16 a1, a2;
#pragma unroll
      for (int r = 0; r < 16; ++r) { a1[r] = 0.f; a2[r] = 0.f; }
#pragma unroll
      for (int kk = 0; kk < 4; ++kk) { const bf16x8 a = *(const bf16x8*)(sP + (tt * 32 + ql) * 72 + kk * 16 + half * 8), bb = tr_frag(sV, 160, kk * 16, vc * 32, lane);
          a1 = MFMA32(a, bb, a1); }
#pragma unroll
      for (int kk = 0; kk < 8; ++kk) { const bf16x8 a = *(const bf16x8*)(sQ + (tt * 32 + ql) * 136 + kk * 16 + half * 8), bb = *(const bf16x8*)(sCt + (vc * 32 + ql) * 136 + kk * 16 + half * 8);
          a2 = MFMA32(a, bb, a2); }
#pragma unroll
      for (int r = 0; r < 16; ++r) { const int t = tt * 32 + 8 * (r >> 2) + 4 * half + (r & 3);
          sH[t * 132 + vc * 32 + ql] = (a1[r] + a_wi[t] * a2[r]) * a_scl[t]; } }
    __syncthreads();
    { const int t = tid >> 3, part = tid & 7; f32x4 hv[4]; float ssq = 0.f;
#pragma unroll
      for (int k = 0; k < 4; ++k) { hv[k] = *(const f32x4*)(sH + t * 132 + part * 16 + k * 4); ssq += dot4(hv[k]); }
      ssq += __shfl_xor(ssq, 1); ssq += __shfl_xor(ssq, 2); ssq += __shfl_xor(ssq, 4);
      const float rstd = rsqrtf(ssq * (1.f / 128.f) + EPS);
      const float* gh = P.in[13] + h * 128 + part * 16;
      bf16* dst = MIX + (size_t)(rowbase + t) * DM + h * 128 + part * 16;
#pragma unroll
      for (int k2 = 0; k2 < 2; ++k2) { const u32x4 ow = k2 ? om1 : om0; const f32x4 g0 = *(const f32x4*)(gh + k2 * 8), g1 = *(const f32x4*)(gh + k2 * 8 + 4);
          const f32x4 h0 = hv[2 * k2], h1 = hv[2 * k2 + 1]; float r[8];
          r[0] = sigmoidf_(bflo(ow.x)) * h0.x * rstd * g0.x; r[1] = sigmoidf_(bfhi(ow.x)) * h0.y * rstd * g0.y; r[2] = sigmoidf_(bflo(ow.y)) * h0.z * rstd * g0.z; r[3] = sigmoidf_(bfhi(ow.y)) * h0.w * rstd * g0.w;
          r[4] = sigmoidf_(bflo(ow.z)) * h1.x * rstd * g1.x; r[5] = sigmoidf_(bfhi(ow.z)) * h1.y * rstd * g1.y; r[6] = sigmoidf_(bflo(ow.w)) * h1.z * rstd * g1.z; r[7] = sigmoidf_(bfhi(ow.w)) * h1.w * rstd * g1.w;
          u32x4 w; w.x = pk2(r[0], r[1]); w.y = pk2(r[2], r[3]); w.z = pk2(r[4], r[5]); w.w = pk2(r[6], r[7]);
          *(u32x4*)(dst + k2 * 8) = w; } }
    __syncthreads();
}

DI void mls_item(const Params& P, unsigned char* lds, int it) {
    const int tid = threadIdx.x, lane = tid & 63, wave = tid >> 6;
    float* sq = (float*)lds; float* sk = sq + 32 * 132; float* sv = sk + 32 * 132; float* sc0 = (float*)(lds + 50688);
    float* sS = (float*)(lds + 116224); float* ar = (float*)(lds + 120448); float* sHs = (float*)(lds + 122880);
    float* a_e = ar, *a_mx = ar + 32, *a_wi = ar + 64, *a_enm = ar + 96, *a_ws = ar + 128, *a_scl = ar + 160, *a_n0 = ar + 192, *a_sc = ar + 320;
    const int pp8 = it & 7, bh = it >> 3, b = bh >> 2, h = bh & 3, rowbase = MP + b * 32, t0 = pp8 * 4;
    const bf16* PROJ = (const bf16*)(P.ws + WS_PROJ); const float* GT = (const float*)(P.ws + WS_GATES); bf16* MIX = (bf16*)(P.ws + WS_H1);
    const float* c0g = P.in[4] + (size_t)(b * 4 + h) * 16384; const float* n0g = P.in[5] + (size_t)(b * 4 + h) * 128; const float m0 = P.in[6][b * 4 + h];
    { const int t = tid >> 4, dg = tid & 15; const bf16* src = PROJ + (size_t)(rowbase + t) * NPROJ + h * 128 + dg * 8;
      const u32x4 qw = *(const u32x4*)(src + C_QM), kw = *(const u32x4*)(src + C_KM), vw = *(const u32x4*)(src + C_VM);
#pragma unroll
      for (int e = 0; e < 4; ++e) { sq[t * 132 + dg * 8 + 2 * e] = bflo(qw[e]); sq[t * 132 + dg * 8 + 2 * e + 1] = bfhi(qw[e]);
          sk[t * 132 + dg * 8 + 2 * e] = bflo(kw[e]); sk[t * 132 + dg * 8 + 2 * e + 1] = bfhi(kw[e]);
          sv[t * 132 + dg * 8 + 2 * e] = bflo(vw[e]); sv[t * 132 + dg * 8 + 2 * e + 1] = bfhi(vw[e]); } }
    { f32x4 cv[8];
#pragma unroll
      for (int j = 0; j < 8; ++j) cv[j] = *(const f32x4*)(c0g + (tid + 512 * j) * 4);
#pragma unroll
      for (int j = 0; j < 8; ++j) *(f32x4*)(sc0 + (tid + 512 * j) * 4) = cv[j]; }
    if (tid < 128) a_n0[tid] = n0g[tid];
    if (wave == 0) {
        const bool ok = lane < 32; const int r = rowbase + (lane & 31);
        const float iv = ok ? GT[(size_t)r * 8 + h] : -1e30f, lf = ok ? GT[(size_t)r * 8 + 4 + h] : 0.f;
        const float bb = wave_scan_add(lf, lane), B = __shfl(bb, 31), e = iv - bb, pm = wave_scan_max(e, lane), mxv = fmaxf(m0, pm);
        const float mt = bb + mxv, mnew = __shfl(mt, 31);
        if (ok) { a_e[lane] = e; a_mx[lane] = mxv; a_wi[lane] = __expf(m0 - mxv); a_enm[lane] = __expf(-mt); a_ws[lane] = __expf(B + e - mnew); }
        if (lane == 0) { a_sc[0] = __expf(B + m0 - mnew); if (pp8 == 0) P.out[O_SM + b * 4 + h] = mnew; }
    }
    __syncthreads();
    if (tid < 128) { const int t = t0 + (tid >> 5), s = tid & 31; float val = 0.f;
        if (s <= t) { float d = 0.f;
#pragma unroll 4
            for (int k = 0; k < 32; ++k) { const f32x4 a = *(const f32x4*)(sq + t * 132 + k * 4), c = *(const f32x4*)(sk + s * 132 + k * 4); d += (a.x * c.x + a.y * c.y) + (a.z * c.z + a.w * c.w); }
            val = d * __expf(a_e[s] - a_mx[t]); }
        sS[t * 33 + s] = val; }
    __syncthreads();
    if (tid < 4) { const int t = t0 + tid; float s = 0.f, qn = 0.f;
#pragma unroll 4
        for (int k = 0; k < 32; ++k) s += sS[t * 33 + k];
#pragma unroll 4
        for (int d = 0; d < 128; ++d) qn += sq[t * 132 + d] * a_n0[d];
        const float den = s + a_wi[t] * qn; a_scl[t] = 1.f / fmaxf(fabsf(den), a_enm[t]); }
    __syncthreads();
    { const int v = tid & 127, tg = tid >> 7, t = t0 + tg; float a1 = 0.f, a2 = 0.f;
#pragma unroll 4
      for (int s = 0; s < 32; ++s) a1 += sS[t * 33 + s] * sv[s * 132 + v];
#pragma unroll 4
      for (int d = 0; d < 128; ++d) a2 += sq[t * 132 + d] * sc0[d * 128 + v];
      sHs[t * 132 + v] = (a1 + a_wi[t] * a2) * a_scl[t];
      const float w_c = a_sc[0]; float* oc = P.out + O_SC + (size_t)(b * 4 + h) * 16384;
#pragma unroll 1
      for (int dd = 0; dd < 4; ++dd) { const int d = pp8 * 16 + tg * 4 + dd; float acc = w_c * sc0[d * 128 + v];
#pragma unroll 4
          for (int s = 0; s < 32; ++s) acc += (a_ws[s] * sk[s * 132 + d]) * sv[s * 132 + v];
          oc[d * 128 + v] = acc; }
      if (tid < 16) { const int d = pp8 * 16 + tid; float acc = w_c * a_n0[d];
#pragma unroll 4
          for (int s = 0; s < 32; ++s) acc += a_ws[s] * sk[s * 132 + d];
          P.out[O_SN + (b * 4 + h) * 128 + d] = acc; } }
    __syncthreads();
    if (tid < 64) { const int t = t0 + (tid >> 4), part = tid & 15; const f32x4 h0 = *(const f32x4*)(sHs + t * 132 + part * 8), h1 = *(const f32x4*)(sHs + t * 132 + part * 8 + 4);
      float ssq = dot4(h0) + dot4(h1);
      ssq += __shfl_xor(ssq, 1); ssq += __shfl_xor(ssq, 2); ssq += __shfl_xor(ssq, 4); ssq += __shfl_xor(ssq, 8);
      const float rstd = rsqrtf(ssq * (1.f / 128.f) + EPS);
      const bf16* om = PROJ + (size_t)(rowbase + t) * NPROJ + C_OM + h * 128 + part * 8; const float* gh = P.in[13] + h * 128 + part * 8;
      const u32x4 ow = *(const u32x4*)om; const f32x4 g0 = *(const f32x4*)gh, g1 = *(const f32x4*)(gh + 4); float r[8];
      r[0] = sigmoidf_(bflo(ow.x)) * h0.x * rstd * g0.x; r[1] = sigmoidf_(bfhi(ow.x)) * h0.y * rstd * g0.y; r[2] = sigmoidf_(bflo(ow.y)) * h0.z * rstd * g0.z; r[3] = sigmoidf_(bfhi(ow.y)) * h0.w * rstd * g0.w;
      r[4] = sigmoidf_(bflo(ow.z)) * h1.x * rstd * g1.x; r[5] = sigmoidf_(bfhi(ow.z)) * h1.y * rstd * g1.y; r[6] = sigmoidf_(bflo(ow.w)) * h1.z * rstd * g1.z; r[7] = sigmoidf_(bfhi(ow.w)) * h1.w * rstd * g1.w;
      u32x4 w; w.x = pk2(r[0], r[1]); w.y = pk2(r[2], r[3]); w.z = pk2(r[4], r[5]); w.w = pk2(r[6], r[7]);
      *(u32x4*)(MIX + (size_t)(rowbase + t) * DM + h * 128 + part * 8) = w; }
    __syncthreads();
}

DI void final_norm(const Params& P, int bid, int G, int nrows) {
    const int lane = threadIdx.x & 63, wave = threadIdx.x >> 6; const float* __restrict__ gf = P.in[22]; const float* __restrict__ ssq = (const float*)(P.ws + WS_SSQA);
    const bf16* __restrict__ X3 = (const bf16*)(P.ws + WS_X1B); float* __restrict__ out = P.out;
    const f32x4 g0 = *(const f32x4*)(gf + lane * 8), g1 = *(const f32x4*)(gf + lane * 8 + 4), g2 = *(const f32x4*)(gf + lane * 8 + 512), g3 = *(const f32x4*)(gf + lane * 8 + 516);
    const int NW = G * 8;
    for (int r0 = bid * 8 + wave; r0 < nrows; r0 += 2 * NW) {
        const int r1 = r0 + NW; const bool two = r1 < nrows; const int r1c = two ? r1 : r0;
        const u32x4 a0 = *(const u32x4*)(X3 + (size_t)r0 * DM + lane * 8), a1 = *(const u32x4*)(X3 + (size_t)r0 * DM + lane * 8 + 512);
        const u32x4 b0 = *(const u32x4*)(X3 + (size_t)r1c * DM + lane * 8), b1 = *(const u32x4*)(X3 + (size_t)r1c * DM + lane * 8 + 512);
        const float rs0 = row_rstd(ssq, r0), rs1 = row_rstd(ssq, r1c);
        float* y0 = out + (size_t)r0 * DM + lane * 8; float* y1 = out + (size_t)r1c * DM + lane * 8;
        *(f32x4*)(y0) = (f32x4){bflo(a0.x), bfhi(a0.x), bflo(a0.y), bfhi(a0.y)} * rs0 * g0; *(f32x4*)(y0 + 4) = (f32x4){bflo(a0.z), bfhi(a0.z), bflo(a0.w), bfhi(a0.w)} * rs0 * g1;
        *(f32x4*)(y0 + 512) = (f32x4){bflo(a1.x), bfhi(a1.x), bflo(a1.y), bfhi(a1.y)} * rs0 * g2; *(f32x4*)(y0 + 516) = (f32x4){bflo(a1.z), bfhi(a1.z), bflo(a1.w), bfhi(a1.w)} * rs0 * g3;
        if (two) {
        *(f32x4*)(y1) = (f32x4){bflo(b0.x), bfhi(b0.x), bflo(b0.y), bfhi(b0.y)} * rs1 * g0; *(f32x4*)(y1 + 4) = (f32x4){bflo(b0.z), bfhi(b0.z), bflo(b0.w), bfhi(b0.w)} * rs1 * g1;
        *(f32x4*)(y1 + 512) = (f32x4){bflo(b1.x), bfhi(b1.x), bflo(b1.y), bfhi(b1.y)} * rs1 * g2; *(f32x4*)(y1 + 516) = (f32x4){bflo(b1.z), bfhi(b1.z), bflo(b1.w), bfhi(b1.w)} * rs1 * g3; }
    }
}

#define LAS __attribute__((address_space(3)))
#define XB_TMO      128
#define XB_XCNT(j)  (256  + 64 * (j))
#define XB_XSUB(j)  (1280 + 64 * (j))
#define XB_XGEN(j)  (2304 + 64 * (j))
#define XB_TOP      3328
#define XB_TOPGEN   3392
#define XCD_BAR_WORDS 3456
#define XB_SPIN_CAP (1u << 18)

__device__ __forceinline__ unsigned xb_ld(unsigned* p)              { return __hip_atomic_load(p, __ATOMIC_RELAXED, __HIP_MEMORY_SCOPE_AGENT); }
__device__ __forceinline__ unsigned xb_add(unsigned* p, unsigned v) { return __hip_atomic_fetch_add(p, v, __ATOMIC_RELAXED, __HIP_MEMORY_SCOPE_AGENT); }
__device__ __forceinline__ unsigned xb_xcc_id() { return (unsigned)__builtin_amdgcn_s_getreg((3 << 11) | 20) & 0xFu; }
#define XB_SPIN(cond, bar) do { unsigned _sp = 0; while (cond) { __builtin_amdgcn_s_sleep(1); \
    if ((++_sp & 255u) == 0u) { if (xb_ld(&(bar)[XB_TMO])) break; if (_sp > XB_SPIN_CAP) { atomicAdd(&(bar)[XB_TMO], 1u); break; } } } } while (0)

struct XcdBarrier {
    unsigned* bar; unsigned x;
    volatile LAS unsigned* st;
};

__device__ __forceinline__ XcdBarrier xcd_barrier_post(unsigned* bar, volatile LAS unsigned* st) {
    XcdBarrier b; b.bar = bar; b.x = xb_xcc_id(); b.st = st;
    if (threadIdx.x == 0) (void)xb_add(&bar[XB_XCNT(b.x)], 1u);
    return b;
}
__device__ __forceinline__ void xcd_barrier_complete(unsigned* bar, unsigned x, unsigned& nloc, unsigned& nx) {
    const unsigned G = gridDim.x * gridDim.y * gridDim.z;
    unsigned sum, cnt, mine, sp = 0u;
    for (;;) {
        sum = 0u; cnt = 0u; mine = 0u;
#pragma unroll
        for (unsigned j = 0; j < 16; ++j) { const unsigned c = xb_ld(&bar[XB_XCNT(j)]); sum += c; cnt += (c > 0u) ? 1u : 0u; mine = (j == x) ? c : mine; }
        if (sum == G) break;
        __builtin_amdgcn_s_sleep(1);
        if ((++sp & 255u) == 0u) { if (xb_ld(&bar[XB_TMO])) break; if (sp > XB_SPIN_CAP) { atomicAdd(&bar[XB_TMO], 1u); break; } }
    }
    nloc = mine > 0u ? mine : 1u; nx = cnt > 0u ? cnt : 1u;
}

__device__ __forceinline__ void xcd_barrier(const XcdBarrier& b) {
    asm volatile("s_waitcnt vmcnt(0)" ::: "memory");
    __syncthreads();
    if (threadIdx.x == 0) {
        unsigned* bar = b.bar;
        __builtin_amdgcn_s_waitcnt(0);
        unsigned nloc = b.st[0], nx = b.st[1];
        if (nloc == 0u) { xcd_barrier_complete(bar, b.x, nloc, nx); b.st[0] = nloc; b.st[1] = nx; }
        const unsigned old = xb_add(&bar[XB_XSUB(b.x)], 1u);
        const unsigned gen = old / nloc;
        if (old + 1u == (gen + 1u) * nloc) {
            __builtin_amdgcn_fence(__ATOMIC_RELEASE, "agent");
            asm volatile("s_waitcnt vmcnt(0)" ::: "memory");
            const unsigned og = xb_add(&bar[XB_TOP], 1u);
            const unsigned tg = og / nx;
            if (og + 1u == (tg + 1u) * nx) xb_add(&bar[XB_TOPGEN], 1u);
            else XB_SPIN(xb_ld(&bar[XB_TOPGEN]) == tg, bar);
            __builtin_amdgcn_fence(__ATOMIC_ACQUIRE, "agent");
            xb_add(&bar[XB_XGEN(b.x)], 1u);
            asm volatile("s_waitcnt vmcnt(0)" ::: "memory");
        } else {
            XB_SPIN(xb_ld(&bar[XB_XGEN(b.x)]) == gen, bar);
            __builtin_amdgcn_fence(__ATOMIC_ACQUIRE, "agent");
            asm volatile("s_waitcnt vmcnt(0)" ::: "memory");
        }
    }
    __syncthreads();
}


__global__ void __launch_bounds__(512, 2) hymba_fwd(Params P) {
    extern __shared__ __attribute__((aligned(16))) unsigned char lds_raw[];
    cg::grid_group grid = cg::this_grid();
    PG8_LAS unsigned char* ldsg = (PG8_LAS unsigned char*)lds_raw;
    unsigned char* lds = lds_raw;
    const int bid = blockIdx.x, G = gridDim.x, lo = P.ph_lo, hi = P.ph_hi;
    unsigned char* ws = P.ws;
    volatile LAS unsigned* bst = (volatile LAS unsigned*)(ldsg + (LDS_BYTES - 64));
    if (threadIdx.x < 2) bst[threadIdx.x] = 0u;
    __syncthreads();
    XcdBarrier xbar; xbar.bar = (unsigned*)(ws + WS_BAR); xbar.x = 0; xbar.st = nullptr;
    if (hi - lo > 1) xbar = xcd_barrier_post((unsigned*)(ws + WS_BAR), bst);
#ifndef TST
#define TST 31
#endif
#ifndef PH_MASK
#define PH_MASK 0x3ff
#endif
#define IN(k) (((PH_MASK >> (k)) & 1) && lo <= (k) && (k) < hi)
#define SEAM(k) do { if (IN(k) && IN((k) + 1)) { if (lo < 0) grid.sync(); xcd_barrier(xbar); } } while (0)
    if (IN(0)) { phase0(P, lds, bid, G); } SEAM(0);
    if (IN(1)) { pg8::Gemm g{(const bf16*)(ws + WS_H1), (const bf16*)(ws + WS_WIN), MP, NPROJ, DM}; pg8::StaticOrder S; S.init(MP, NPROJ, G, bid);
        EpiStore E{(bf16*)(ws + WS_PROJ), NPROJ}; pg8::gemm_phase<EpiStore, pg8::StaticOrder, true, true>(ldsg, g, S, E);
        SEpiStore SE{(bf16*)(ws + WS_PROJ), NPROJ}; if (G == 256) { if (bid >= 192) small_gemm<DM>(g.A, g.Bt, NPROJ, lds, bid - 192, 64, SE); }
        else small_gemm<DM>(g.A, g.Bt, NPROJ, lds, G - 1 - bid, G, SE); } SEAM(1);
    if (IN(2)) { constexpr int N_AT = 512, N_DC = 1024, N_AS = 16, N_KV = 160;
        if (bid & 1) for (int it = bid; it < N_DC; it += G) dc_item(P, lds, it);
        for (int it = bid; it < N_AT; it += G) attn_item<false>(P, lds, it);
        if (!(bid & 1)) for (int it = bid; it < N_DC; it += G) dc_item(P, lds, it);
        for (int it = G - 1 - bid; it < N_AS; it += G) attn_item<true>(P, lds, it);
        for (int it = bid; it < N_KV; it += G) kvcopy_item(P, it); } SEAM(2);
    if (IN(3)) { for (int it = bid; it < 256; it += G) scan_item(P, lds, it); } SEAM(3);
    if (IN(4)) { if (bid & 1) for (int it = bid; it < 256; it += G) mls_item(P, lds, it);
        { MlR R; if (bid < 1024) ml_load(P, bid, R); for (int it = bid; it < 1024; it += G) ml_item(P, lds, it, R, it + G < 1024 ? it + G : -1); } if (!(bid & 1)) for (int it = bid; it < 256; it += G) mls_item(P, lds, it); } SEAM(4);
    if (IN(5)) { pg8::Gemm g{(const bf16*)(ws + WS_H1), (const bf16*)(ws + WS_WOUT), MP, DM, DM}; pg8::StaticOrder S; S.init(MP, DM, G, bid);
        SEpiResid<false> SE{P.in[1], nullptr, (bf16*)(ws + WS_X1B), (float*)(ws + WS_SSQA)};
        if (bid & 1) small_gemm<DM>(g.A, g.Bt, DM, lds, bid >> 1, G >> 1, SE);
        EpiResid<false> E{P.in[0], nullptr, (bf16*)(ws + WS_X1B), (float*)(ws + WS_SSQA)}; pg8::gemm_phase<EpiResid<false>, pg8::StaticOrder, true, true>(ldsg, g, S, E); } SEAM(5);
    if (IN(6)) { pg8::Gemm g{(const bf16*)(ws + WS_X1B), (const bf16*)(ws + WS_WUP), MP, DFF, DM}; pg8::StaticOrder S; S.init(MP, DFF, G, bid);
        EpiUp E{(bf16*)(ws + WS_U), (const float*)(ws + WS_SSQA)}; SEpiUp SE{(bf16*)(ws + WS_U), (const float*)(ws + WS_SSQA)};
        if (bid & 1) small_gemm<DM>(g.A, g.Bt, DFF, lds, bid, G, SE);
        pg8::gemm_phase<EpiUp, pg8::StaticOrder, true, true>(ldsg, g, S, E);
        if (!(bid & 1)) small_gemm<DM>(g.A, g.Bt, DFF, lds, bid, G, SE); } SEAM(6);
    if (IN(7)) { pg8::Gemm g{(const bf16*)(ws + WS_U), (const bf16*)(ws + WS_WDOWN), MP, DM, DFF}; pg8::StaticOrder S; S.init(MP, DM, G, bid);
        SEpiResid<true> SE{nullptr, (const bf16*)(ws + WS_X1B), (bf16*)(ws + WS_H1), (float*)(ws + WS_SSQB)};
        if (bid & 1) small_gemm<DFF>(g.A, g.Bt, DM, lds, bid >> 1, G >> 1, SE);
        EpiResid<true> E{nullptr, (const bf16*)(ws + WS_X1B), (bf16*)(ws + WS_H1), (float*)(ws + WS_SSQB)}; pg8::gemm_phase<EpiResid<true>, pg8::StaticOrder, true, true>(ldsg, g, S, E); } SEAM(7);
    if (IN(8)) { pg8::Gemm gp{(const bf16*)(ws + WS_PB), (const bf16*)(ws + WS_WPP), MP, DM, PLE}; pg8::Gemm g{(const bf16*)(ws + WS_H1), (const bf16*)(ws + WS_WGATE), MP, DM, DM};
        unsigned* cnt = (unsigned*)(ws + WS_CNT);
        if (bid & 1) {
          SEpiStore SEp{(bf16*)(ws + WS_PP), DM}; small_gemm<PLE>(gp.A, gp.Bt, DM, lds, bid >> 1, G >> 1, SEp);
          SEpiPle SE{(const bf16*)(ws + WS_H1), (const bf16*)(ws + WS_PP), (bf16*)(ws + WS_X1B), (const float*)(ws + WS_SSQB), (float*)(ws + WS_SSQA)};
          small_gemm<DM, SEpiPle, FUSE_FINAL != 0>(g.A, g.Bt, DM, lds, bid >> 1, G >> 1, SE, cnt, P.in[22], P.out); }
        { pg8::StaticOrder S; S.init(MP, DM, G, bid); EpiStore E{(bf16*)(ws + WS_PP), DM}; pg8::gemm_phase<EpiStore, pg8::StaticOrder, true, true>(ldsg, gp, S, E); }
        { pg8::StaticOrder S; S.init(MP, DM, G, bid);
          if (FUSE_FINAL && G == 256) { EpiPleNorm E{(const bf16*)(ws + WS_H1), (const bf16*)(ws + WS_PP), P.out, (const float*)(ws + WS_SSQB), (float*)(ws + WS_SSQA), cnt, P.in[22]};
              pg8::gemm_phase<EpiPleNorm, pg8::StaticOrder, true, true>(ldsg, g, S, E); }
          else { EpiPle E{(const bf16*)(ws + WS_H1), (const bf16*)(ws + WS_PP), (bf16*)(ws + WS_X1B), (const float*)(ws + WS_SSQB), (float*)(ws + WS_SSQA)};
              pg8::gemm_phase<EpiPle, pg8::StaticOrder, true, true>(ldsg, g, S, E); } } } SEAM(8);
    if (IN(9)) { if (!FUSE_FINAL) final_norm(P, bid, G, MT); else if (G != 256) final_norm(P, bid, G, MP); }
#undef IN
#undef SEAM
}

constexpr int N_PHASES = 10;
#ifndef REP_MASK
#define REP_MASK 0
#endif
#ifndef MK_ONE_LAUNCH
#define MK_ONE_LAUNCH 1
#endif
extern "C" void kernel_launch(void* const* d_in, const int* in_sizes, int n_in, void* d_out, int out_size, void* d_ws, size_t ws_size, hipStream_t stream) {
    static int grid_blocks = 0;
    if (!grid_blocks) {
        int dev = 0, cus = 0, per_cu = 0;
        hipGetDevice(&dev);
        hipDeviceGetAttribute(&cus, hipDeviceAttributeMultiprocessorCount, dev);
        hipFuncSetAttribute((const void*)hymba_fwd, hipFuncAttributeMaxDynamicSharedMemorySize, LDS_BYTES);
        hipOccupancyMaxActiveBlocksPerMultiprocessor(&per_cu, (const void*)hymba_fwd, 512, LDS_BYTES);
        if (per_cu < 1) { fprintf(stderr, "kernel_launch: occupancy query says %d blocks per CU\n", per_cu); per_cu = 1; }
        grid_blocks = cus * per_cu;
        if (n_in != 23 || ws_size < 256 * MiB) fprintf(stderr, "kernel_launch: unexpected n_in %d / ws_size %zu\n", n_in, ws_size);
    }
    Params p{};
    for (int i = 0; i < 23; ++i) p.in[i] = (const float*)d_in[i];
    p.out = (float*)d_out; p.ws = (unsigned char*)d_ws;
#if MK_ONE_LAUNCH
    (void)hipMemsetAsync((unsigned char*)d_ws + WS_BAR, 0, 16384, stream);
#if FUSE_FINAL
    (void)hipMemsetAsync((unsigned char*)d_ws + WS_CNT, 0, 32768, stream);
#endif
    p.ph_lo = 0; p.ph_hi = N_PHASES;
    void* args[] = {&p};
    hipError_t e = hipLaunchCooperativeKernel((const void*)hymba_fwd, dim3(grid_blocks), dim3(512), args, LDS_BYTES, stream);
    if (e != hipSuccess) fprintf(stderr, "cooperative launch failed: %s (grid %d)\n", hipGetErrorString(e), grid_blocks);
#else
    for (int k = 0; k < N_PHASES; ++k) { p.ph_lo = k; p.ph_hi = k + 1;
        for (int rep = 0; rep < (((REP_MASK >> k) & 1) ? 2 : 1); ++rep) hipLaunchKernelGGL(hymba_fwd, dim3(grid_blocks), dim3(512), LDS_BYTES, stream, p); }
#endif
}
```
